# Optimizing an MI355X kernel written in HIP

```python
import jax, jax.numpy as jnp
from jax import lax
import numpy as np

D_MODEL = 1024
BATCH = 8
SEQ = 2048
DEPTH = 2
DEC_BATCH = 128
DEC_SEQ = 8
PAST_LEN = 16384
PAGE_SIZE = 128

W_A = D_MODEL // 2
W_B = D_MODEL // 2
W_C = D_MODEL // 2
W_D = D_MODEL // 2
K_A = 3
K_B = 31
POOL_WINDOWS = (2, 4, 8, 16)
N_POOL_GROUPS = len(POOL_WINDOWS)
POOL_GROUP = W_C // N_POOL_GROUPS
POOL_HIST = max(POOL_WINDOWS) - 1
CHUNK = 128
N_SGU_GROUPS = 4
SGU_GROUP = W_D // N_SGU_GROUPS
D_FF = 4 * D_MODEL
N_EVEN = (DEPTH + 1) // 2
N_ODD = DEPTH // 2
EPS = 1e-6

kernel_name = "hybrid_conv_pool_sgu_decoder_step"


def rms_norm(x, g):
    xf = x.astype(jnp.float32)
    y = xf * lax.rsqrt(jnp.mean(xf * xf, axis=-1, keepdims=True) + EPS)
    return (y * g.astype(jnp.float32)).astype(x.dtype)


def layer_norm(x, g, b):
    xf = x.astype(jnp.float32)
    mu = jnp.mean(xf, axis=-1, keepdims=True)
    xc = xf - mu
    y = xc * lax.rsqrt(jnp.mean(xc * xc, axis=-1, keepdims=True) + EPS)
    return (y * g.astype(jnp.float32) + b.astype(jnp.float32)).astype(x.dtype)


def causal_dwconv(xp, w):
    return lax.conv_general_dilated(
        xp, w[:, None, :], window_strides=(1,), padding='VALID',
        dimension_numbers=('NWC', 'WIO', 'NWC'), feature_group_count=xp.shape[-1])


def even_mixer(h, hist_a, hist_b, w_in, conv_a, conv_b, conv_b_bias, ln_g, ln_b, w_out):
    z = h @ w_in
    gate_b, gate_c, xa, ga, gb = jnp.split(
        z, [W_A, 2 * W_A, 3 * W_A, 3 * W_A + W_B], axis=-1)
    ua_p = jnp.concatenate([hist_a, gate_c * xa], axis=1)
    ya = gate_b * causal_dwconv(ua_p, conv_a)
    ub_p = jnp.concatenate([hist_b, ga * jax.nn.sigmoid(gb)], axis=1)
    cb = causal_dwconv(ub_p, conv_b) + conv_b_bias
    yb = jax.nn.silu(layer_norm(cb, ln_g, ln_b))
    y = jnp.concatenate([ya, yb], axis=-1) @ w_out
    return y, ua_p[:, -(K_A - 1):], ub_p[:, -(K_B - 1):]


def pool_mix(p, start_pos, w_pool, pool_scale):
    n, L, _ = p.shape
    T = L - POOL_HIST
    pf = p.astype(jnp.float32)
    cs = jnp.concatenate([jnp.zeros((n, 1, W_C), jnp.float32), jnp.cumsum(pf, axis=1)], axis=1)
    pos = jnp.arange(T, dtype=jnp.int32) + start_pos
    means = []
    for g, w in enumerate(POOL_WINDOWS):
        csg = cs[..., g * POOL_GROUP:(g + 1) * POOL_GROUP]
        wsum = csg[:, POOL_HIST + 1:] - csg[:, POOL_HIST + 1 - w:POOL_HIST + 1 - w + T]
        cnt = jnp.minimum(pos + 1, w).astype(jnp.float32)
        means.append(wsum / cnt[None, :, None])
    mean = jnp.stack(means, axis=2)
    tok = pf[:, POOL_HIST:].reshape(n, T, N_POOL_GROUPS, POOL_GROUP)
    d = (mean - tok).astype(p.dtype)
    y = jnp.einsum('btgc,gcd->btgd', d, w_pool).reshape(n, T, W_C)
    return y * pool_scale


def sgu_mix(u, v, w_s, b_s, ln_g, ln_b):
    n, T, _ = v.shape
    nc = -(-T // CHUNK)
    Tp = nc * CHUNK
    vn = layer_norm(v, ln_g, ln_b)
    vp = jnp.pad(vn, ((0, 0), (0, Tp - T), (0, 0))).reshape(n, nc, CHUNK, N_SGU_GROUPS, SGU_GROUP)
    mask = jnp.tril(jnp.ones((CHUNK, CHUNK), dtype=bool))
    wm = jnp.where(mask[None], w_s, 0)
    mixed = jnp.einsum('gts,bcsgd->bctgd', wm, vp) + b_s.T[None, None, :, :, None]
    mixed = mixed.reshape(n, Tp, W_D)[:, :T]
    return u * mixed, vn


def odd_mixer(h, hist_c, start_pos, w_in, w_pool, pool_scale, sgu_w, sgu_b, sgu_ln_g, sgu_ln_b, w_out):
    z = h @ w_in
    pc, u, v = jnp.split(z, [W_C, W_C + W_D], axis=-1)
    pc_p = jnp.concatenate([hist_c, pc], axis=1)
    yc = pool_mix(pc_p, start_pos, w_pool, pool_scale)
    yd, vn = sgu_mix(u, v, sgu_w, sgu_b, sgu_ln_g, sgu_ln_b)
    y = jnp.concatenate([yc, yd], axis=-1) @ w_out
    return y, pc_p[:, -POOL_HIST:], vn


def setup_inputs(seed: int = 0) -> dict:
    key = jax.random.key(seed)
    ks = iter(jax.random.split(key, 32))

    def nrm(shape, scale):
        return jax.random.normal(next(ks), shape, jnp.float32) * scale

    return {
        "x_prompt": nrm((BATCH, SEQ, D_MODEL), 1.0),
        "x_sample": nrm((DEC_BATCH, DEC_SEQ, D_MODEL), 1.0),
        "state_conv_a": nrm((N_EVEN, DEC_BATCH, K_A - 1, W_A), 1.0),
        "state_conv_b": nrm((N_EVEN, DEC_BATCH, K_B - 1, W_B), 0.5),
        "state_pool": nrm((N_ODD, DEC_BATCH, POOL_HIST, W_C), 1.0),
        "norm_mix": 1.0 + nrm((DEPTH, D_MODEL), 0.02),
        "norm_ffn": 1.0 + nrm((DEPTH, D_MODEL), 0.02),
        "ev_w_in": nrm((N_EVEN, D_MODEL, 3 * W_A + 2 * W_B), D_MODEL ** -0.5),
        "ev_conv_a": nrm((N_EVEN, K_A, W_A), K_A ** -0.5),
        "ev_conv_b": nrm((N_EVEN, K_B, W_B), K_B ** -0.5),
        "ev_conv_b_bias": nrm((N_EVEN, W_B), 0.02),
        "ev_ln_g": 1.0 + nrm((N_EVEN, W_B), 0.02),
        "ev_ln_b": nrm((N_EVEN, W_B), 0.02),
        "ev_w_out": nrm((N_EVEN, W_A + W_B, D_MODEL), (W_A + W_B) ** -0.5),
        "od_w_in": nrm((N_ODD, D_MODEL, W_C + 2 * W_D), D_MODEL ** -0.5),
        "od_pool_w": nrm((N_ODD, N_POOL_GROUPS, POOL_GROUP, POOL_GROUP), POOL_GROUP ** -0.5),
        "od_pool_scale": 1.0 + nrm((N_ODD, W_C), 0.1),
        "od_sgu_w": nrm((N_ODD, N_SGU_GROUPS, CHUNK, CHUNK), CHUNK ** -0.5),
        "od_sgu_b": 1.0 + nrm((N_ODD, N_SGU_GROUPS, CHUNK), 0.02),
        "od_sgu_ln_g": 1.0 + nrm((N_ODD, W_D), 0.02),
        "od_sgu_ln_b": nrm((N_ODD, W_D), 0.02),
        "od_w_out": nrm((N_ODD, W_C + W_D, D_MODEL), (W_C + W_D) ** -0.5),
        "ffn_w1": nrm((DEPTH, D_MODEL, D_FF), D_MODEL ** -0.5),
        "ffn_w2": nrm((DEPTH, D_FF, D_MODEL), D_FF ** -0.5),
        "norm_final": 1.0 + nrm((D_MODEL,), 0.02),
    }


def reference(x_prompt, x_sample, state_conv_a, state_conv_b, state_pool,
              norm_mix, norm_ffn, ev_w_in, ev_conv_a, ev_conv_b, ev_conv_b_bias,
              ev_ln_g, ev_ln_b, ev_w_out, od_w_in, od_pool_w, od_pool_scale,
              od_sgu_w, od_sgu_b, od_sgu_ln_g, od_sgu_ln_b, od_w_out,
              ffn_w1, ffn_w2, norm_final):

    def run(x, start_pos, hist_a, hist_b, hist_c):
        sa_l, sb_l, sc_l, v_l = [], [], [], []
        for l in range(DEPTH):
            i = l // 2
            h = rms_norm(x, norm_mix[l])
            if l % 2 == 0:
                y, sa, sb = even_mixer(h, hist_a[i], hist_b[i], ev_w_in[i], ev_conv_a[i],
                                       ev_conv_b[i], ev_conv_b_bias[i], ev_ln_g[i],
                                       ev_ln_b[i], ev_w_out[i])
                sa_l.append(sa)
                sb_l.append(sb)
            else:
                y, sc, vn = odd_mixer(h, hist_c[i], start_pos, od_w_in[i], od_pool_w[i],
                                      od_pool_scale[i], od_sgu_w[i], od_sgu_b[i],
                                      od_sgu_ln_g[i], od_sgu_ln_b[i], od_w_out[i])
                sc_l.append(sc)
                v_l.append(vn)
            x = x + y
            hf = rms_norm(x, norm_ffn[l])
            x = x + jnp.square(jax.nn.relu(hf @ ffn_w1[l])) @ ffn_w2[l]
        return (rms_norm(x, norm_final), jnp.stack(sa_l), jnp.stack(sb_l),
                jnp.stack(sc_l), jnp.stack(v_l))

    dt = x_prompt.dtype
    zeros_a = jnp.zeros((N_EVEN, BATCH, K_A - 1, W_A), dt)
    zeros_b = jnp.zeros((N_EVEN, BATCH, K_B - 1, W_B), dt)
    zeros_c = jnp.zeros((N_ODD, BATCH, POOL_HIST, W_C), dt)
    y_prompt, new_conv_a_prompt, new_conv_b_prompt, new_pool_prompt, _ = run(
        x_prompt, 0, zeros_a, zeros_b, zeros_c)
    y_sample, new_conv_a_sample, new_conv_b_sample, new_pool_sample, new_chunk_v_sample = run(
        x_sample, PAST_LEN, state_conv_a, state_conv_b, state_pool)
    return (y_prompt, y_sample, new_conv_a_prompt, new_conv_a_sample,
            new_conv_b_prompt, new_conv_b_sample, new_pool_prompt, new_pool_sample,
            new_chunk_v_sample)
```

```cpp
#include <hip/hip_runtime.h>
#include <hip/hip_cooperative_groups.h>
#include <cstdio>
#include <cstdint>
namespace cg = cooperative_groups;
namespace pg8 {
#define PG8_LAS __attribute__((address_space(3)))
typedef unsigned short bf16_t;
typedef short bf16x8 __attribute__((ext_vector_type(8)));
typedef float f32x4 __attribute__((ext_vector_type(4)));
typedef unsigned u32x4 __attribute__((ext_vector_type(4)));
constexpr int BM = 256, BK = 64, HALF = 128, HTB = HALF * BK * 2  , STAGE_BYTES = 8 * HTB, NXCD = 8, WGM = 8;

__host__ __device__ __forceinline__ int lds_byte(int r, int c) { const int st = (r >> 4) * 2 + (c >> 5), rr = r & 15, cc = c & 31, ob = rr * 64 + cc * 2; return st * 1024 + (ob ^ (((ob >> 9) & 1) << 5)); }
__host__ __device__ __forceinline__ void stage_rc(int b, int& R, int& C) { const int st = b / 1024, sb = b % 1024, swz = sb ^ (((sb >> 9) & 1) << 5); R = (st >> 1) * 16 + swz / 64; C = (st & 1) * 32 + (swz % 64) / 2; }
__host__ __device__ __forceinline__ int perm32(int rho) { const int n = rho >> 4, i = rho & 15; return 8 * (i >> 2) + 4 * n + (i & 3); }

struct Unit { int pm, pn, k0, nt, sp, qa, qb; };
struct Gemm { const bf16_t* A; const bf16_t* Bt; int M, N, K, lda; size_t kstepA, tstepA; int asub; };

struct StaticOrder {
    int nM, nN, nwg, G, c, ntK;
    __host__ __device__ __forceinline__ void init(int M, int N, int K, int G_, int c_) { nM = M / BM; nN = N / BM; nwg = nM * nN; G = G_; c = c_; ntK = K / BK; }
    __host__ __device__ __forceinline__ void map(int L, Unit& u) const {
        int wgid = L; { const int q = nwg / NXCD, r = nwg % NXCD, xcd = wgid % NXCD, off = wgid / NXCD; wgid = (xcd < r ? xcd * (q + 1) : r * (q + 1) + (xcd - r) * q) + off; }
        const int nig = WGM * nN, gid = wgid / nig, fm = gid * WGM, gsz = (nM - fm) < WGM ? (nM - fm) : WGM;
        u.pm = fm + ((wgid % nig) % gsz); u.pn = (wgid % nig) / gsz; u.k0 = 0; u.nt = ntK; u.sp = -1; u.qa = -1; u.qb = -1;
    }
    __host__ __device__ __forceinline__ bool next(int i, Unit& u) const { const long L = (long)i * G + c; if (L >= nwg) return false; map((int)L, u); return true; }
    __device__ __forceinline__ void a_ready(const Unit&) const {}
    __device__ __forceinline__ void done(const Unit&) const {}
};
struct FixOrder : StaticOrder {
    const unsigned* cnt; unsigned need;
    __device__ __forceinline__ void a_ready(const Unit& u) const {
        if (u.pm < 64) return;
        if (threadIdx.x < 64) {
            unsigned spins = 0;
            while ((unsigned)__builtin_amdgcn_readfirstlane(__hip_atomic_load(cnt, __ATOMIC_RELAXED, __HIP_MEMORY_SCOPE_AGENT)) < need && ++spins < (1u << 22)) __builtin_amdgcn_s_sleep(2);
            __builtin_amdgcn_fence(__ATOMIC_ACQUIRE, "agent");
            asm volatile("s_waitcnt vmcnt(0)" ::: "memory");
        }
        asm volatile("" ::: "memory"); __builtin_amdgcn_s_barrier(); asm volatile("" ::: "memory");
    }
};
struct QuarterOrder : FixOrder {
    StaticOrder sp_; int nq;
    __host__ __device__ __forceinline__ void initq(int N, int K, int G_, int c_) { sp_.init(16384, N, K, G_, c_); init(17408, N, K, G_, c_); nq = 4 * 4 * (N / BM); }
    __host__ __device__ __forceinline__ bool next(int i, Unit& u) const {
        const int L = i * sp_.G + sp_.c; const bool isp = L < sp_.nwg; const int j = isp ? 0 : L - sp_.nwg;
        Unit a; sp_.map(isp ? L : 0, a);
        const int s = j >> 2;
        u.pm = isp ? a.pm : 64 + s / sp_.nN; u.pn = isp ? a.pn : s % sp_.nN; u.k0 = 0; u.nt = a.nt; u.sp = -1; u.qa = isp ? -1 : ((j >> 1) & 1); u.qb = isp ? -1 : (j & 1);
        return isp || j < nq;
    }
};
struct ResidOrder {
    StaticOrder so; int S, ntS;
    __host__ __device__ __forceinline__ void init(int K, int S_, int G_, int c_) { so.init(16384, 1024, K, G_, c_); S = S_; ntS = K / BK / S_; }
    __host__ __device__ __forceinline__ bool next(int i, Unit& u) const {
        const int ii = (so.c < 16 * S && so.G >= so.nwg && i < 2) ? 1 - i : i;
        const int L = ii * so.G + so.c; const bool isp = L < so.nwg; const int j = isp ? 0 : L - so.nwg;
        Unit a; so.map(isp ? L : 0, a);
        const int q = j / S, sp = j - q * S;
        u.pm = isp ? a.pm : 64 + (q >> 2); u.pn = isp ? a.pn : (q & 3); u.sp = isp ? -1 : sp; u.nt = isp ? a.nt : ntS; u.k0 = isp ? 0 : sp * ntS * BK; u.qa = -1; u.qb = -1;
        return isp || j < 16 * S;
    }
    __device__ __forceinline__ void a_ready(const Unit&) const {}
    __device__ __forceinline__ void done(const Unit&) const {}
};
__device__ __forceinline__ unsigned cvt_pk_bf16(float lo, float hi) { unsigned r; asm volatile("v_cvt_pk_bf16_f32 %0, %1, %2" : "=v"(r) : "v"(lo), "v"(hi)); return r; }
typedef float f32x2 __attribute__((ext_vector_type(2)));
constexpr float RMS_EPS = 1e-6f;
template <int ACT, bool BLK = false, bool STATS = false> struct EpiScaleBf16 {
    static constexpr bool PERM = true, AFTER_DRAIN = false;
    bf16_t* O; int ldc; const float* ss; float* st1; float* st2; int stat_pn0;
    __device__ __forceinline__ void operator()(const f32x4 (&acc)[2][2][4][2], const Unit& u, int wr, int wc, int fr, int fq) const {
        const bool whole = u.qa < 0;
        const int row0 = u.pm * BM + wr * 64 + fr + (u.qa > 0 ? HALF : 0), col0 = u.pn * BM + wc * 32 + 8 * fq + (u.qb > 0 ? HALF : 0);
        float rsv[2][4];
#pragma unroll
        for (int ai = 0; ai < 2; ++ai)
#pragma unroll
            for (int m = 0; m < 4; ++m) rsv[ai][m] = ss[row0 + ai * HALF + m * 16];
#pragma unroll
        for (int ai = 0; ai < 2; ++ai)
#pragma unroll
            for (int m = 0; m < 4; ++m) rsv[ai][m] = __builtin_amdgcn_rsqf(rsv[ai][m] * (1.0f / 1024.0f) + RMS_EPS);
#pragma unroll
        for (int ai = 0; ai < 2; ++ai)
#pragma unroll
            for (int m = 0; m < 4; ++m) {
                if (ai == 1 && !whole) continue;
                const int row = row0 + ai * HALF + m * 16;
                const float rs = rsv[ai][m];
                float s1 = 0.f, s2 = 0.f;
                bf16_t* rowp = BLK ? O + ((size_t)u.pm * (ldc >> 6) + (size_t)(col0 >> 6)) * 16384 + (size_t)((col0 >> 5) & 1) * 8192 + (size_t)(row - u.pm * BM) * 32 + (col0 & 31) : O + (size_t)row * ldc + col0;
#pragma unroll
                for (int bj = 0; bj < 2; ++bj) {
                    if (bj == 1 && !whole) continue;
                    f32x4 v0 = acc[ai][bj][m][0] * rs, v1 = acc[ai][bj][m][1] * rs;
                    if (ACT == 1) {
#pragma unroll
                        for (int j = 0; j < 4; ++j) { const float a = fmaxf(v0[j], 0.f), b = fmaxf(v1[j], 0.f); v0[j] = a * a; v1[j] = b * b; }
                    }
                    u32x4 w; w.x = cvt_pk_bf16(v0[0], v0[1]); w.y = cvt_pk_bf16(v0[2], v0[3]); w.z = cvt_pk_bf16(v1[0], v1[1]); w.w = cvt_pk_bf16(v1[2], v1[3]);
                    *(u32x4*)(rowp + (BLK ? bj * 2 * 16384 : bj * HALF)) = w;
                    if (STATS) { s1 += (v0[0] + v0[1]) + (v0[2] + v0[3]) + (v1[0] + v1[1]) + (v1[2] + v1[3]);
                        s2 += (v0[0] * v0[0] + v0[1] * v0[1]) + (v0[2] * v0[2] + v0[3] * v0[3]) + (v1[0] * v1[0] + v1[1] * v1[1]) + (v1[2] * v1[2] + v1[3] * v1[3]); }
                }
                if (STATS && u.pn >= stat_pn0) {
                    s1 += __shfl_xor(s1, 16); s1 += __shfl_xor(s1, 32); s2 += __shfl_xor(s2, 16); s2 += __shfl_xor(s2, 32);
                    if (fq == 0) { atomicAdd(st1 + row, s1); atomicAdd(st2 + row, s2); }
                }
            }
    }
};
struct EpiGate {
    static constexpr bool PERM = true, AFTER_DRAIN = false;
    bf16_t* O; const float* ss;
    __device__ __forceinline__ void operator()(const f32x4 (&acc)[2][2][4][2], const Unit& u, int wr, int wc, int fr, int fq) const {
        const int row0 = u.pm * BM + wr * 64 + fr, wcol = wc * 32 + 8 * fq;
        float rsv[2][4];
#pragma unroll
        for (int ai = 0; ai < 2; ++ai)
#pragma unroll
            for (int m = 0; m < 4; ++m) rsv[ai][m] = ss[row0 + ai * HALF + m * 16];
#pragma unroll
        for (int ai = 0; ai < 2; ++ai)
#pragma unroll
            for (int m = 0; m < 4; ++m) rsv[ai][m] = __builtin_amdgcn_rsqf(rsv[ai][m] * (1.0f / 1024.0f) + RMS_EPS);
#pragma unroll
        for (int ai = 0; ai < 2; ++ai)
#pragma unroll
            for (int m = 0; m < 4; ++m) {
                const int row = row0 + ai * HALF + m * 16;
                const float rs = rsv[ai][m];
                bf16_t* rowp = O + (size_t)row * 1536;
                const f32x4 a0 = acc[ai][0][m][0] * rs, a1 = acc[ai][0][m][1] * rs, b0 = acc[ai][1][m][0] * rs, b1 = acc[ai][1][m][1] * rs;
                if (u.pn < 2) {
                    u32x4 w; w.x = cvt_pk_bf16(a0[0], a0[1]); w.y = cvt_pk_bf16(a0[2], a0[3]); w.z = cvt_pk_bf16(a1[0], a1[1]); w.w = cvt_pk_bf16(a1[2], a1[3]);
                    *(u32x4*)(rowp + u.pn * 256 + wcol) = w;
                    w.x = cvt_pk_bf16(b0[0], b0[1]); w.y = cvt_pk_bf16(b0[2], b0[3]); w.z = cvt_pk_bf16(b1[0], b1[1]); w.w = cvt_pk_bf16(b1[2], b1[3]);
                    *(u32x4*)(rowp + u.pn * 256 + 128 + wcol) = w;
                } else {
                    f32x4 r0, r1;
                    if (u.pn < 6) { r0 = a0 * b0; r1 = a1 * b1; }
                    else {
#pragma unroll
                        for (int j = 0; j < 4; ++j) { r0[j] = a0[j] * __builtin_amdgcn_rcpf(1.0f + __expf(-b0[j])); r1[j] = a1[j] * __builtin_amdgcn_rcpf(1.0f + __expf(-b1[j])); }
                    }
                    u32x4 w; w.x = cvt_pk_bf16(r0[0], r0[1]); w.y = cvt_pk_bf16(r0[2], r0[3]); w.z = cvt_pk_bf16(r1[0], r1[1]); w.w = cvt_pk_bf16(r1[2], r1[3]);
                    *(u32x4*)(rowp + (u.pn < 6 ? 512 + (u.pn - 2) * 128 : 1024 + (u.pn - 6) * 128) + wcol) = w;
                }
            }
    }
};
template <bool FUSE> struct EpiResid {
    static constexpr bool PERM = true, AFTER_DRAIN = false;
    bf16_t* xb; float* xout; float* ss; float* part;
    const float* gfin; unsigned* cnt;
    __device__ __forceinline__ void operator()(const f32x4 (&acc)[2][2][4][2], const Unit& u, int wr, int wc, int fr, int fq) const {
        const int row0 = u.pm * BM + wr * 64 + fr, col0 = u.pn * BM + wc * 32 + 8 * fq;
        if (u.sp >= 0) {
            float* pb = part + ((size_t)u.sp * 1024 + (row0 - 16384)) * 1024 + col0;
#pragma unroll
            for (int ai = 0; ai < 2; ++ai)
#pragma unroll
                for (int m = 0; m < 4; ++m)
#pragma unroll
                    for (int bj = 0; bj < 2; ++bj) { float* q = pb + (size_t)(ai * HALF + m * 16) * 1024 + bj * HALF; *(f32x4*)q = acc[ai][bj][m][0]; *(f32x4*)(q + 4) = acc[ai][bj][m][1]; }
            return;
        }
        if (FUSE) {
            f32x4 (&a)[2][2][4][2] = const_cast<f32x4 (&)[2][2][4][2]>(acc);
#pragma unroll
            for (int ai = 0; ai < 2; ++ai)
#pragma unroll
                for (int m = 0; m < 4; ++m) {
                    const int row = row0 + ai * HALF + m * 16;
                    const bf16_t* xr = xb + (size_t)row * 1024 + col0;
                    float part_ss = 0.f;
#pragma unroll
                    for (int bj = 0; bj < 2; ++bj) {
                        const u32x4 o = *(const u32x4*)(xr + bj * HALF);
                        f32x4 v0 = a[ai][bj][m][0], v1 = a[ai][bj][m][1];
                        v0[0] += __uint_as_float(o.x << 16); v0[1] += __uint_as_float(o.x & 0xffff0000u); v0[2] += __uint_as_float(o.y << 16); v0[3] += __uint_as_float(o.y & 0xffff0000u);
                        v1[0] += __uint_as_float(o.z << 16); v1[1] += __uint_as_float(o.z & 0xffff0000u); v1[2] += __uint_as_float(o.w << 16); v1[3] += __uint_as_float(o.w & 0xffff0000u);
                        a[ai][bj][m][0] = v0; a[ai][bj][m][1] = v1;
                        part_ss += (v0[0] * v0[0] + v0[1] * v0[1]) + (v0[2] * v0[2] + v0[3] * v0[3]) + (v1[0] * v1[0] + v1[1] * v1[1]) + (v1[2] * v1[2] + v1[3] * v1[3]);
                    }
                    part_ss += __shfl_xor(part_ss, 16); part_ss += __shfl_xor(part_ss, 32);
                    if (fq == 0) { const float old = atomicAdd(ss + row, part_ss); asm volatile("" :: "v"(old)); }
                    __builtin_amdgcn_sched_barrier(0);
                }
            asm volatile("s_waitcnt vmcnt(0)" ::: "memory");
            __syncthreads();
            if (threadIdx.x == 0) {
                unsigned* c = cnt + 64 * u.pm;
                __hip_atomic_fetch_add(c, 1u, __ATOMIC_RELAXED, __HIP_MEMORY_SCOPE_AGENT);
                unsigned spins = 0;
                while (__hip_atomic_load(c, __ATOMIC_RELAXED, __HIP_MEMORY_SCOPE_AGENT) < 4u && ++spins < (1u << 22)) __builtin_amdgcn_s_sleep(2);
            }
            __syncthreads();
#pragma unroll
            for (int ai = 0; ai < 2; ++ai)
#pragma unroll
                for (int m = 0; m < 4; ++m) {
                    const int row = row0 + ai * HALF + m * 16;
                    const float ssv = atomicAdd(ss + row, 0.0f);
                    const float rs = __builtin_amdgcn_rsqf(ssv * (1.0f / 1024.0f) + RMS_EPS);
#pragma unroll
                    for (int bj = 0; bj < 2; ++bj) {
                        const f32x4 g0 = *(const f32x4*)(gfin + col0 + bj * HALF), g1 = *(const f32x4*)(gfin + col0 + bj * HALF + 4);
                        float* xo = xout + (size_t)row * 1024 + col0 + bj * HALF;
                        *(f32x4*)xo = a[ai][bj][m][0] * rs * g0; *(f32x4*)(xo + 4) = a[ai][bj][m][1] * rs * g1;
                    }
                    __builtin_amdgcn_sched_barrier(0);
                }
            return;
        }
        u32x4 xo[2][4][2];
#pragma unroll
        for (int ai = 0; ai < 2; ++ai)
#pragma unroll
            for (int m = 0; m < 4; ++m)
#pragma unroll
                for (int bj = 0; bj < 2; ++bj) xo[ai][m][bj] = *(const u32x4*)(xb + (size_t)(row0 + ai * HALF + m * 16) * 1024 + col0 + bj * HALF);
#pragma unroll
        for (int ai = 0; ai < 2; ++ai)
#pragma unroll
            for (int m = 0; m < 4; ++m) {
                const int row = row0 + ai * HALF + m * 16;
                bf16_t* xr = xb + (size_t)row * 1024 + col0;
                float part_ss = 0.f;
#pragma unroll
                for (int bj = 0; bj < 2; ++bj) {
                    const u32x4 o = xo[ai][m][bj];
                    f32x4 v0 = acc[ai][bj][m][0], v1 = acc[ai][bj][m][1];
                    v0[0] += __uint_as_float(o.x << 16); v0[1] += __uint_as_float(o.x & 0xffff0000u); v0[2] += __uint_as_float(o.y << 16); v0[3] += __uint_as_float(o.y & 0xffff0000u);
                    v1[0] += __uint_as_float(o.z << 16); v1[1] += __uint_as_float(o.z & 0xffff0000u); v1[2] += __uint_as_float(o.w << 16); v1[3] += __uint_as_float(o.w & 0xffff0000u);
                    if (xout) { float* xo = xout + (size_t)row * 1024 + col0 + bj * HALF; *(f32x4*)xo = v0; *(f32x4*)(xo + 4) = v1; }
                    else { u32x4 w; w.x = cvt_pk_bf16(v0[0], v0[1]); w.y = cvt_pk_bf16(v0[2], v0[3]); w.z = cvt_pk_bf16(v1[0], v1[1]); w.w = cvt_pk_bf16(v1[2], v1[3]); *(u32x4*)(xr + bj * HALF) = w; }
                    part_ss += (v0[0] * v0[0] + v0[1] * v0[1]) + (v0[2] * v0[2] + v0[3] * v0[3]) + (v1[0] * v1[0] + v1[1] * v1[1]) + (v1[2] * v1[2] + v1[3] * v1[3]);
                }
                part_ss += __shfl_xor(part_ss, 16); part_ss += __shfl_xor(part_ss, 32);
                if (fq == 0) atomicAdd(ss + row, part_ss);
            }
    }
};
template <class Epi, class Sched, bool ALIGN_EPI = false, bool SP2 = false>
__device__ __forceinline__ void gemm_phase(PG8_LAS unsigned char* lds, const Gemm g, const Sched& S, const Epi& E) {
    int tid_ = threadIdx.x; asm volatile("" : "+v"(tid_));
    const int tid = tid_, wid = __builtin_amdgcn_readfirstlane(tid >> 6), lane = tid & 63, wr = wid >> 2, wc = wid & 3, fr = lane & 15, fq = lane >> 4;
    const int K = g.K;
    unsigned voffA[2], voffB[2];
#pragma unroll
    for (int i = 0; i < 2; ++i) { int R, C; stage_rc(tid * 16 + i * 8192, R, C); const int Rb = Epi::PERM ? ((R & ~31) + perm32(R & 31)) : R;
        voffA[i] = g.asub ? (unsigned)((C >> 5) * 16384 + (R * 32 + (C & 31)) * 2) : (unsigned)(R * g.lda + C) * 2u; voffB[i] = (unsigned)(Rb * K + C) * 2u; }
    const size_t kstep = (size_t)(BK * 2);
    const size_t hstepB = (size_t)HALF * K * 2, hstepA = (size_t)HALF * g.lda * 2;
    const size_t tstepB = 2 * hstepB, tstepA = g.tstepA; const size_t kstepA = g.kstepA;
    const unsigned ldsw = (unsigned)wid * 1024u;
    const int aoff = lds_byte(wr * 64 + fr, fq * 8), boff = lds_byte(wc * 32 + fr, fq * 8);
#define PG8_SA(b, h) (((b) * 2 + (h)) * HTB)
#define PG8_SB(b, h) ((4 + (b) * 2 + (h)) * HTB)
#define PG8_STAGE(bufoff, gbase, voff) do { _Pragma("unroll") for (int _i = 0; _i < 2; ++_i) \
        __builtin_amdgcn_global_load_lds((const unsigned*)((const char*)(gbase) + (voff)[_i]), (PG8_LAS unsigned*)(lds + (bufoff) + ldsw + _i * 8192), 16, 0, 0); } while (0)
#define PG8_LDA(dst, b, h) do { _Pragma("unroll") for (int m = 0; m < 4; ++m) _Pragma("unroll") for (int k = 0; k < 2; ++k) dst[m][k] = *(const PG8_LAS bf16x8*)(lds + PG8_SA(b, h) + aoff + m * 2048 + k * 1024); } while (0)
#define PG8_LDB(dst, b, h) do { _Pragma("unroll") for (int n = 0; n < 2; ++n) _Pragma("unroll") for (int k = 0; k < 2; ++k) dst[n][k] = *(const PG8_LAS bf16x8*)(lds + PG8_SB(b, h) + boff + n * 2048 + k * 1024); } while (0)
#define PG8_MMA(ai, bj, At, Bt) do { __builtin_amdgcn_s_setprio(1); _Pragma("unroll") for (int m = 0; m < 4; ++m) _Pragma("unroll") for (int n = 0; n < 2; ++n) _Pragma("unroll") for (int k = 0; k < 2; ++k) \
        acc[ai][bj][m][n] = __builtin_amdgcn_mfma_f32_16x16x32_bf16(Bt[n][k], At[m][k], acc[ai][bj][m][n], 0, 0, 0); __builtin_amdgcn_s_setprio(0); } while (0)
#define PG8_WAIT_V(n) asm volatile("s_waitcnt vmcnt(" #n ")" ::: "memory")
#define PG8_WAIT_L(n) asm volatile("s_waitcnt lgkmcnt(" #n ")" ::: "memory")
#define PG8_BAR __builtin_amdgcn_s_barrier()
#define PG8_SCHED __builtin_amdgcn_sched_barrier(0)
    Unit cur, nxt; int ui = 0;
    if (!S.next(0, cur)) return;
    f32x4 acc[2][2][4][2];
#pragma unroll
    for (int a = 0; a < 2; ++a)
#pragma unroll
        for (int b = 0; b < 2; ++b)
#pragma unroll
            for (int m = 0; m < 4; ++m)
#pragma unroll
                for (int n = 0; n < 2; ++n) acc[a][b][m][n] = (f32x4){0.f, 0.f, 0.f, 0.f};
    bf16x8 At[4][2], B0[2][2], B1[2][2];
    const char* cA = (const char*)g.A + (size_t)cur.pm * tstepA + (size_t)(cur.k0 >> 6) * kstepA + (cur.qa > 0 ? hstepA : (size_t)0); const char* cB = (const char*)g.Bt + (size_t)cur.pn * tstepB + (size_t)cur.k0 * 2 + (cur.qb > 0 ? hstepB : (size_t)0);
    S.a_ready(cur);
    if constexpr (SP2) {
        PG8_STAGE(PG8_SB(0, 0), cB, voffB); PG8_STAGE(PG8_SB(0, 1), cB + hstepB, voffB); PG8_STAGE(PG8_SA(0, 0), cA, voffA); PG8_STAGE(PG8_SA(0, 1), cA + hstepA, voffA);
        if (wr == 1) PG8_BAR;
        PG8_WAIT_V(2); PG8_BAR;
        PG8_STAGE(PG8_SB(1, 0), cB + kstep, voffB); PG8_STAGE(PG8_SA(1, 0), cA + kstepA, voffA); PG8_STAGE(PG8_SB(1, 1), cB + hstepB + kstep, voffB);
        PG8_WAIT_V(6); PG8_BAR;
    } else {
        PG8_STAGE(PG8_SB(0, 0), cB, voffB); PG8_STAGE(PG8_SA(0, 0), cA, voffA); PG8_STAGE(PG8_SB(0, 1), cB + hstepB, voffB); PG8_STAGE(PG8_SA(0, 1), cA + hstepA, voffA);
        if (wr == 1) PG8_BAR;
        PG8_WAIT_V(4); PG8_BAR;
        PG8_STAGE(PG8_SB(1, 0), cB + kstep, voffB); PG8_STAGE(PG8_SA(1, 0), cA + kstepA, voffA); PG8_STAGE(PG8_SB(1, 1), cB + hstepB + kstep, voffB);
        PG8_WAIT_V(6); PG8_BAR;
    }
    for (;;) {
        const bool has_next = S.next(ui + 1, nxt);
        const char* nA = has_next ? (const char*)g.A + (size_t)nxt.pm * tstepA + (size_t)(nxt.k0 >> 6) * kstepA + (nxt.qa > 0 ? hstepA : (size_t)0) : cA; const char* nB = has_next ? (const char*)g.Bt + (size_t)nxt.pn * tstepB + (size_t)nxt.k0 * 2 + (nxt.qb > 0 ? hstepB : (size_t)0) : cB;
        const bool whole = cur.qa < 0;
        const int nt = cur.nt;
        for (int t = 0; t < nt; t += 2) {
            const bool last = (t == nt - 2);
            const char* a1 = cA + (size_t)(t + 1) * kstepA;
            const char* a2 = last ? nA : cA + (size_t)(t + 2) * kstepA; const char* b2 = last ? nB : cB + (size_t)(t + 2) * kstep;
            const char* a3 = a2 + kstepA; const char* b3 = b2 + kstep;
            if (last && has_next) S.a_ready(nxt);
            if constexpr (SP2) {
            PG8_LDB(B0, 0, 0); PG8_LDB(B1, 0, 1); PG8_SCHED; PG8_LDA(At, 0, 0); PG8_STAGE(PG8_SA(1, 1), a1 + hstepA, voffA);
            PG8_WAIT_V(8); PG8_WAIT_L(0); PG8_BAR; PG8_MMA(0, 0, At, B0); if (whole) PG8_MMA(0, 1, At, B1); PG8_BAR; PG8_SCHED;
            PG8_LDA(At, 0, 1); PG8_STAGE(PG8_SB(0, 0), b2, voffB); PG8_STAGE(PG8_SB(0, 1), b2 + hstepB, voffB); PG8_STAGE(PG8_SA(0, 0), a2, voffA);
            PG8_WAIT_V(8); PG8_WAIT_L(0); PG8_BAR; if (whole) { PG8_MMA(1, 0, At, B0); PG8_MMA(1, 1, At, B1); } PG8_BAR; PG8_SCHED;
            PG8_LDB(B0, 1, 0); PG8_LDB(B1, 1, 1); PG8_SCHED; PG8_LDA(At, 1, 0); PG8_STAGE(PG8_SA(0, 1), a2 + hstepA, voffA);
            PG8_WAIT_V(8); PG8_WAIT_L(0); PG8_BAR; PG8_MMA(0, 0, At, B0); if (whole) PG8_MMA(0, 1, At, B1); PG8_BAR; PG8_SCHED;
            PG8_LDA(At, 1, 1); PG8_STAGE(PG8_SB(1, 0), b3, voffB); PG8_STAGE(PG8_SB(1, 1), b3 + hstepB, voffB); PG8_STAGE(PG8_SA(1, 0), a3, voffA);
            PG8_WAIT_V(8); PG8_WAIT_L(0); PG8_BAR; if (whole) { PG8_MMA(1, 0, At, B0); PG8_MMA(1, 1, At, B1); } PG8_BAR; PG8_SCHED;
            } else {
            PG8_LDB(B0, 0, 0); PG8_SCHED; PG8_LDA(At, 0, 0); PG8_STAGE(PG8_SA(1, 1), a1 + hstepA, voffA);
            PG8_WAIT_L(8); PG8_BAR; PG8_WAIT_L(0); PG8_MMA(0, 0, At, B0); PG8_BAR; PG8_SCHED;
            PG8_LDB(B1, 0, 1); PG8_STAGE(PG8_SB(0, 0), b2, voffB);
            PG8_BAR; PG8_WAIT_L(0); PG8_MMA(0, 1, At, B1); PG8_BAR;
            PG8_LDA(At, 0, 1); PG8_STAGE(PG8_SA(0, 0), a2, voffA);
            PG8_BAR; PG8_WAIT_L(0); PG8_MMA(1, 0, At, B0); PG8_BAR; PG8_SCHED;
            PG8_STAGE(PG8_SB(0, 1), b2 + hstepB, voffB);
            PG8_WAIT_V(6); PG8_BAR; PG8_MMA(1, 1, At, B1); PG8_BAR;
            PG8_LDB(B0, 1, 0); PG8_SCHED; PG8_LDA(At, 1, 0); PG8_STAGE(PG8_SA(0, 1), a2 + hstepA, voffA);
            PG8_WAIT_L(8); PG8_BAR; PG8_WAIT_L(0); PG8_MMA(0, 0, At, B0); PG8_BAR; PG8_SCHED;
            PG8_LDB(B1, 1, 1); PG8_STAGE(PG8_SB(1, 0), b3, voffB);
            PG8_BAR; PG8_WAIT_L(0); PG8_MMA(0, 1, At, B1); PG8_BAR;
            PG8_LDA(At, 1, 1); PG8_STAGE(PG8_SA(1, 0), a3, voffA);
            PG8_BAR; PG8_WAIT_L(0); PG8_MMA(1, 0, At, B0); PG8_BAR; PG8_SCHED;
            PG8_STAGE(PG8_SB(1, 1), b3 + hstepB, voffB);
            PG8_WAIT_V(6); PG8_BAR; PG8_MMA(1, 1, At, B1); PG8_BAR;
            }
        }
        if constexpr (ALIGN_EPI) { if (wr == 0) PG8_BAR; }
        if constexpr (!Epi::AFTER_DRAIN) { E(acc, cur, wr, wc, fr, fq); S.done(cur); }
        if (!has_next) break;
#pragma unroll
        for (int a = 0; a < 2; ++a)
#pragma unroll
            for (int b = 0; b < 2; ++b)
#pragma unroll
                for (int m = 0; m < 4; ++m)
#pragma unroll
                    for (int n = 0; n < 2; ++n) acc[a][b][m][n] = (f32x4){0.f, 0.f, 0.f, 0.f};
        cur = nxt; cA = nA; cB = nB; ++ui;
        if constexpr (ALIGN_EPI) { if (wr == 1) PG8_BAR; }
    }
    PG8_WAIT_V(0);
    if constexpr (!ALIGN_EPI) { if (wr == 0) PG8_BAR; }
    PG8_BAR;
    if constexpr (Epi::AFTER_DRAIN) { E.fused(acc, cur, wr, wc, fr, fq, lds, wid, lane); S.done(cur); }
#undef PG8_SA
#undef PG8_SB
#undef PG8_STAGE
#undef PG8_LDA
#undef PG8_LDB
#undef PG8_MMA
#undef PG8_WAIT_V
#undef PG8_WAIT_L
#undef PG8_BAR
#undef PG8_SCHED
}
}
#define LAS __attribute__((address_space(3)))
typedef unsigned short bf16;
typedef unsigned v4u __attribute__((ext_vector_type(4)));
typedef unsigned v2u __attribute__((ext_vector_type(2)));
typedef float f32x4 __attribute__((ext_vector_type(4)));
typedef short bf16x8 __attribute__((ext_vector_type(8)));

constexpr int D = 1024, MP = 16384, MS = 1024, M = MP + MS, FF = 4096, NZ0 = 2560, NZ1 = 1536, SEQ = 2048;
constexpr float EPS = 1e-6f;
constexpr size_t OUT_Y = 0, OUT_CA_P = 17825792, OUT_CA_S = 17833984, OUT_CB_P = 17965056, OUT_CB_S = 18087936, OUT_PL_P = 20054016, OUT_PL_S = 20115456, OUT_V_S = 21098496, OUT_TOTAL = 21622784;
constexpr size_t MiB = 1u << 20;
constexpr size_t WS_SS = 0;
constexpr size_t WS_BAR = 512 * 1024;
constexpr size_t WS_WIN0 = 1 * MiB, WS_WOUT0 = 6 * MiB, WS_W1_0 = 8 * MiB, WS_W2_0 = 16 * MiB, WS_WIN1 = 24 * MiB, WS_WOUT1 = 27 * MiB, WS_W1_1 = 29 * MiB, WS_W2_1 = 37 * MiB, WS_SGUW = 45 * MiB;
constexpr size_t WS_XB = 46 * MiB;
constexpr size_t WS_H = 80 * MiB;
constexpr size_t WS_Z = 80 * MiB;
constexpr size_t WS_YMIX = 166 * MiB;
constexpr size_t WS_PART = 219 * MiB;
constexpr size_t WS_END = 251 * MiB;
constexpr int LDH = FF + 64;
constexpr int S_OUT = 4, S_FFN2 = 8;
constexpr int LDS_BYTES = 147456;

struct Params { const float* in[25]; float* out; unsigned char* ws; int ph_lo, ph_hi; };

__device__ __forceinline__ float wave_sum(float v) {
#pragma unroll
    for (int o = 1; o < 64; o <<= 1) v += __shfl_xor(v, o);
    return v;
}
__device__ __forceinline__ unsigned pk2(float lo, float hi) { return pg8::cvt_pk_bf16(lo, hi); }
__device__ __forceinline__ void unpack8(const v4u w, float (&f)[8]) {
    f[0] = __uint_as_float(w.x << 16); f[1] = __uint_as_float(w.x & 0xffff0000u); f[2] = __uint_as_float(w.y << 16); f[3] = __uint_as_float(w.y & 0xffff0000u);
    f[4] = __uint_as_float(w.z << 16); f[5] = __uint_as_float(w.z & 0xffff0000u); f[6] = __uint_as_float(w.w << 16); f[7] = __uint_as_float(w.w & 0xffff0000u);
}
__device__ __forceinline__ v4u pack8(const float (&f)[8]) { v4u w; w.x = pk2(f[0], f[1]); w.y = pk2(f[2], f[3]); w.z = pk2(f[4], f[5]); w.w = pk2(f[6], f[7]); return w; }
__device__ __forceinline__ void load8f(const float* p, float (&f)[8]) { const f32x4 a = *(const f32x4*)p, b = *(const f32x4*)(p + 4); f[0] = a[0]; f[1] = a[1]; f[2] = a[2]; f[3] = a[3]; f[4] = b[0]; f[5] = b[1]; f[6] = b[2]; f[7] = b[3]; }
__device__ __forceinline__ void store8f(float* p, const float (&f)[8]) { *(f32x4*)p = (f32x4){f[0], f[1], f[2], f[3]}; *(f32x4*)(p + 4) = (f32x4){f[4], f[5], f[6], f[7]}; }
__device__ __forceinline__ float sigmoidf_fast(float x) { return __builtin_amdgcn_rcpf(1.0f + __expf(-x)); }

typedef __attribute__((address_space(1))) unsigned gu32;
#define RLX_AGENT __ATOMIC_RELAXED, __HIP_MEMORY_SCOPE_AGENT
#define XB_TMO      128
#define XB_XCNT(j)  (256  + 64 * (j))
#define XB_XSUB(j)  (1280 + 64 * (j))
#define XB_XGEN(j)  (2304 + 64 * (j))
#define XB_TOP      3328
#define XB_TOPGEN   3392
#define XCD_BAR_WORDS 3456
#define XB_SPIN_CAP (1u << 18)

__device__ __forceinline__ unsigned xb_ld(unsigned* p)              { return __hip_atomic_load(p, __ATOMIC_RELAXED, __HIP_MEMORY_SCOPE_AGENT); }
__device__ __forceinline__ unsigned xb_add(unsigned* p, unsigned v) { return __hip_atomic_fetch_add(p, v, __ATOMIC_RELAXED, __HIP_MEMORY_SCOPE_AGENT); }
__device__ __forceinline__ unsigned xb_xcc_id() { return (unsigned)__builtin_amdgcn_s_getreg((3 << 11) | 20) & 0xFu; }
#define XB_SPIN(cond, bar) do { unsigned _sp = 0; while (cond) { __builtin_amdgcn_s_sleep(1); \
    if ((++_sp & 255u) == 0u) { if (xb_ld(&(bar)[XB_TMO])) break; if (_sp > XB_SPIN_CAP) { atomicAdd(&(bar)[XB_TMO], 1u); break; } } } } while (0)

struct XcdBarrier {
    unsigned* bar; unsigned x;
    volatile LAS unsigned* st;
};

__device__ __forceinline__ XcdBarrier xcd_barrier_post(unsigned* bar, volatile LAS unsigned* st) {
    XcdBarrier b; b.bar = bar; b.x = xb_xcc_id(); b.st = st;
    if (threadIdx.x == 0) (void)xb_add(&bar[XB_XCNT(b.x)], 1u);
    return b;
}
__device__ __forceinline__ void xcd_barrier_complete(unsigned* bar, unsigned x, unsigned& nloc, unsigned& nx) {
    const unsigned G = gridDim.x * gridDim.y * gridDim.z;
    unsigned sum, cnt, mine, sp = 0u;
    for (;;) {
        sum = 0u; cnt = 0u; mine = 0u;
#pragma unroll
        for (unsigned j = 0; j < 16; ++j) { const unsigned c = xb_ld(&bar[XB_XCNT(j)]); sum += c; cnt += (c > 0u) ? 1u : 0u; mine = (j == x) ? c : mine; }
        if (sum == G) break;
        __builtin_amdgcn_s_sleep(1);
        if ((++sp & 255u) == 0u) { if (xb_ld(&bar[XB_TMO])) break; if (sp > XB_SPIN_CAP) { atomicAdd(&bar[XB_TMO], 1u); break; } }
    }
    nloc = mine > 0u ? mine : 1u; nx = cnt > 0u ? cnt : 1u;
}

__device__ __forceinline__ void xcd_barrier(const XcdBarrier& b) {
    asm volatile("s_waitcnt vmcnt(0)" ::: "memory");
    __syncthreads();
    if (threadIdx.x == 0) {
        unsigned* bar = b.bar;
        __builtin_amdgcn_s_waitcnt(0);
        unsigned nloc = b.st[0], nx = b.st[1];
        if (nloc == 0u) { xcd_barrier_complete(bar, b.x, nloc, nx); b.st[0] = nloc; b.st[1] = nx; }
        const unsigned old = xb_add(&bar[XB_XSUB(b.x)], 1u);
        const unsigned gen = old / nloc;
        if (old + 1u == (gen + 1u) * nloc) {
            __builtin_amdgcn_fence(__ATOMIC_RELEASE, "agent");
            asm volatile("s_waitcnt vmcnt(0)" ::: "memory");
            const unsigned og = xb_add(&bar[XB_TOP], 1u);
            const unsigned tg = og / nx;
            if (og + 1u == (tg + 1u) * nx) xb_add(&bar[XB_TOPGEN], 1u);
            else XB_SPIN(xb_ld(&bar[XB_TOPGEN]) == tg, bar);
            __builtin_amdgcn_fence(__ATOMIC_ACQUIRE, "agent");
            xb_add(&bar[XB_XGEN(b.x)], 1u);
            asm volatile("s_waitcnt vmcnt(0)" ::: "memory");
        } else {
            XB_SPIN(xb_ld(&bar[XB_XGEN(b.x)]) == gen, bar);
            __builtin_amdgcn_fence(__ATOMIC_ACQUIRE, "agent");
            asm volatile("s_waitcnt vmcnt(0)" ::: "memory");
        }
    }
    __syncthreads();
}


__host__ __device__ __forceinline__ int gate_row(int n) { if (n < 512) return n; const int base = n < 1536 ? 512 : 1536, q = n - base, h = q >> 9, t = (q & 511) >> 7, r = q & 127; return base + t * 256 + h * 128 + r; }
template <bool GATEMAP = false>
__device__ __forceinline__ void p0_transpose_item(const float* W, int N, bf16* WT, int ldwt, int koff, const float* gain, LAS float* scr, int item, int lane) {
    const int nblk = N / 64, kb = item / nblk, nb = item % nblk, k0 = 64 * kb, n0 = 64 * nb; const int nd0 = GATEMAP ? gate_row(n0) : n0;
    const int ks = lane >> 4, n4 = (lane & 15) * 4;
    f32x4 v[16];
#pragma unroll
    for (int i = 0; i < 16; ++i) v[i] = *(const f32x4*)(W + (size_t)(k0 + 4 * i + ks) * N + n0 + n4);
    if (gain) {
#pragma unroll
        for (int i = 0; i < 16; ++i) v[i] = v[i] * gain[k0 + 4 * i + ks];
    }
#pragma unroll
    for (int i = 0; i < 16; ++i) { LAS float* d = scr + (4 * i + ks) * 65 + n4; d[0] = v[i][0]; d[1] = v[i][1]; d[2] = v[i][2]; d[3] = v[i][3]; }
    asm volatile("s_waitcnt lgkmcnt(0)" ::: "memory");
    const int c = lane & 7;
#pragma unroll
    for (int j = 0; j < 8; ++j) { const int n = (lane >> 3) + 8 * j; const LAS float* q = scr + (8 * c) * 65 + n;
        v4u o; o.x = pk2(q[0 * 65], q[1 * 65]); o.y = pk2(q[2 * 65], q[3 * 65]); o.z = pk2(q[4 * 65], q[5 * 65]); o.w = pk2(q[6 * 65], q[7 * 65]);
        *(v4u*)(WT + (size_t)(nd0 + n) * ldwt + koff + k0 + 8 * c) = o; }
    asm volatile("s_waitcnt lgkmcnt(0)" ::: "memory");
}
template <int PART>
__device__ __forceinline__ void phase_prologue_late(const Params& p, LAS unsigned char* lds, int cu0) {
    int tid_ = threadIdx.x; asm volatile("" : "+v"(tid_)); const int tid = tid_, lane = tid & 63, wave = __builtin_amdgcn_readfirstlane(tid >> 6);
    if ((int)blockIdx.x < cu0) return;
    const int nb = gridDim.x - cu0, gw = (blockIdx.x - cu0) * 8 + wave, NGW = nb * 8;
    LAS float* scr = (LAS float*)(lds + wave * 16640);
    unsigned char* ws = p.ws;
    constexpr int I_W1 = 16 * 64, I_W2 = 64 * 16, I_IN1 = 16 * 24, I_OUT1 = 8 * 16;
    if (PART == 1) {
        for (int it = gw; it < 16 * 16 + I_W1 + I_IN1 + I_OUT1; it += NGW) {
            int r = it;
            if (r < 16 * 16) { p0_transpose_item(p.in[13], D, (bf16*)(ws + WS_WOUT0), D, 0, nullptr, scr, r, lane); continue; } r -= 16 * 16;
            if (r < I_W1) { p0_transpose_item(p.in[22], FF, (bf16*)(ws + WS_W1_0), D, 0, p.in[6], scr, r, lane); continue; } r -= I_W1;
            if (r < I_IN1) { p0_transpose_item(p.in[14], NZ1, (bf16*)(ws + WS_WIN1), D, 0, p.in[5] + D, scr, r, lane); continue; } r -= I_IN1;
            p0_transpose_item(p.in[21] + (size_t)512 * D, D, (bf16*)(ws + WS_WOUT1), D, 512, nullptr, scr, r, lane);
        }
        return;
    }
    if (PART == 3) {
        for (int it = gw; it < I_W1 + I_W2; it += NGW) {
            int r = it;
            if (r < I_W1) { p0_transpose_item(p.in[22] + (size_t)D * FF, FF, (bf16*)(ws + WS_W1_1), D, 0, p.in[6] + D, scr, r, lane); continue; } r -= I_W1;
            p0_transpose_item(p.in[23] + (size_t)D * FF, D, (bf16*)(ws + WS_W2_1), FF, 0, nullptr, scr, r, lane);
        }
        return;
    }
    for (int it = gw; it < I_W2; it += NGW) p0_transpose_item(p.in[23], D, (bf16*)(ws + WS_W2_0), FF, 0, nullptr, scr, it, lane);
    {
        const float* Wp = p.in[15]; const float* sc = p.in[16]; const float* Wo = p.in[21]; bf16* WT = (bf16*)(ws + WS_WOUT1);
        for (int it = gw; it < 1024; it += NGW) {
            const int g = it >> 8, cb = (it >> 4) & 15, nb2 = it & 15, n = nb2 * 64 + lane;
            float acc[8];
#pragma unroll
            for (int i = 0; i < 8; ++i) acc[i] = 0.f;
            const float* wp = Wp + ((size_t)g * 128 + cb * 8) * 128;
            for (int d0 = 0; d0 < 128; d0 += 16) {
                float wv[16];
#pragma unroll
                for (int dd = 0; dd < 16; ++dd) wv[dd] = Wo[(size_t)(g * 128 + d0 + dd) * D + n];
#pragma unroll
                for (int dd = 0; dd < 16; ++dd) { const float w = wv[dd] * sc[g * 128 + d0 + dd];
#pragma unroll
                    for (int i = 0; i < 8; ++i) acc[i] += wp[i * 128 + d0 + dd] * w; }
            }
            *(v4u*)(WT + (size_t)n * D + g * 128 + cb * 8) = pack8(acc);
        }
    }
    {
        const float* Wsg = p.in[17]; bf16* o = (bf16*)(ws + WS_SGUW);
        for (int i = (blockIdx.x - cu0) * 512 + tid; i < 4 * 128 * 128 / 2; i += nb * 512) {
            const int e = 2 * i, t = (e >> 7) & 127, s2 = e & 127;
            const float a = (s2 <= t) ? Wsg[e] : 0.f, b = (s2 + 1 <= t) ? Wsg[e + 1] : 0.f;
            ((unsigned*)o)[i] = pk2(a, b);
        }
    }
}
__device__ __forceinline__ void phase_prologue(const Params& p, LAS unsigned char* lds) {
    int tid_ = threadIdx.x; asm volatile("" : "+v"(tid_)); const int tid = tid_, lane = tid & 63, wave = __builtin_amdgcn_readfirstlane(tid >> 6);
    const int gw = blockIdx.x * 8 + wave, NGW = gridDim.x * 8;
    LAS float* scr = (LAS float*)(lds + wave * 16640);
    unsigned char* ws = p.ws;
    for (int it = gw; it < 16 * 40; it += NGW) p0_transpose_item<true>(p.in[7], NZ0, (bf16*)(ws + WS_WIN0), D, 0, p.in[5], scr, it, lane);
    { float* ss = (float*)(ws + WS_SS); for (int i = blockIdx.x * 512 + tid; i < 6 * M; i += gridDim.x * 512) ss[M + i] = 0.f; }
    {
        float* ss0 = (float*)(ws + WS_SS); bf16* XB = (bf16*)(ws + WS_XB);
        f32x4 v[2][4], vn[2][4];
#pragma unroll
        for (int h = 0; h < 2; ++h) { const int m = gw + h * NGW;
            if (m < M) { const float* xr = (m < MP) ? p.in[0] + (size_t)m * D : p.in[1] + (size_t)(m - MP) * D;
#pragma unroll
                for (int j = 0; j < 4; ++j) v[h][j] = *((const f32x4*)xr + lane + 64 * j); } }
        for (int m0 = gw; m0 < M; m0 += 2 * NGW) {
#pragma unroll
            for (int h = 0; h < 2; ++h) { const int m = m0 + 2 * NGW + h * NGW;
                if (m < M) { const float* xr = (m < MP) ? p.in[0] + (size_t)m * D : p.in[1] + (size_t)(m - MP) * D;
#pragma unroll
                    for (int j = 0; j < 4; ++j) vn[h][j] = *((const f32x4*)xr + lane + 64 * j); } }
#pragma unroll
            for (int h = 0; h < 2; ++h) { const int m = m0 + h * NGW;
                if (m < M) { float sq = 0.f; unsigned long long* o8 = (unsigned long long*)(XB + (size_t)m * D) + lane;
#pragma unroll
                    for (int j = 0; j < 4; ++j) { const f32x4 w = v[h][j]; sq += (w[0] * w[0] + w[1] * w[1]) + (w[2] * w[2] + w[3] * w[3]);
                        o8[64 * j] = (unsigned long long)pk2(w[0], w[1]) | ((unsigned long long)pk2(w[2], w[3]) << 32); }
                    sq = wave_sum(sq);
                    if (lane == 0) ss0[m] = sq; } }
#pragma unroll
            for (int h = 0; h < 2; ++h)
#pragma unroll
                for (int j = 0; j < 4; ++j) v[h][j] = vn[h][j];
        }
    }
}

__device__ __forceinline__ void phase_mixer0(const Params& p, LAS unsigned char* lds) {
    int tid_ = threadIdx.x; asm volatile("" : "+v"(tid_)); const int tid = tid_, lane = tid & 63, wave = __builtin_amdgcn_readfirstlane(tid >> 6);
    const bf16* Z = (const bf16*)(p.ws + WS_Z); bf16* Y = (bf16*)(p.ws + WS_YMIX);
    const float* st_a = p.in[2]; const float* st_b = p.in[3]; const float* cwa = p.in[8]; const float* cwb = p.in[9];
    const float* lng = p.in[11]; const float* lnb = p.in[12];
    float* o_ca_p = p.out + OUT_CA_P; float* o_ca_s = p.out + OUT_CA_S; float* o_cb_p = p.out + OUT_CB_P; float* o_cb_s = p.out + OUT_CB_S;
    LAS unsigned short* ub = (LAS unsigned short*)lds; LAS float* cb = (LAS float*)(lds + 63488);
    float wb[31];
#pragma unroll
    for (int k = 0; k < 31; ++k) wb[k] = cwb[k * 512 + tid];
    const float bias = p.in[10][tid];
    const int c8 = lane * 8;
    for (int unit = blockIdx.x; unit < 640; unit += gridDim.x) {
        const bool samp = unit >= 512;
        const int seq = samp ? unit - 512 : unit >> 6, t0 = samp ? 0 : (unit & 63) * 32, nout = samp ? 8 : 32;
        const long rowbase = samp ? (long)MP + seq * 8 : (long)seq * SEQ + t0;
        for (int j = wave; j < (samp ? 38 : 62); j += 8) {
            const int tt = t0 - 30 + j;
            float v[8];
            if (j < nout + 30 && tt >= 0) {
                unpack8(*(const v4u*)(Z + (rowbase + (tt - t0)) * NZ1 + 1024 + c8), v);
            } else if (samp && j < 30) {
                load8f(st_b + ((size_t)seq * 30 + j) * 512 + c8, v);
            } else {
#pragma unroll
                for (int i = 0; i < 8; ++i) v[i] = 0.f;
            }
            *(LAS v4u*)(ub + j * 512 + c8) = pack8(v);
            if (!samp) { if (tt >= SEQ - 30) store8f(o_cb_p + ((size_t)seq * 30 + (tt - (SEQ - 30))) * 512 + c8, v); }
            else if (j >= 8 && j < 38) store8f(o_cb_s + ((size_t)seq * 30 + (j - 8)) * 512 + c8, v);
        }
        __syncthreads();
        if (!samp) {
            float acc[32];
#pragma unroll
            for (int t = 0; t < 32; ++t) acc[t] = bias;
#pragma unroll
            for (int j = 0; j < 62; ++j) {
                const float v = __uint_as_float((unsigned)ub[j * 512 + tid] << 16);
#pragma unroll
                for (int t = 0; t < 32; ++t) { if (j - t >= 0 && j - t <= 30) acc[t] += v * wb[j - t]; }
            }
#pragma unroll
            for (int t = 0; t < 32; ++t) cb[t * 512 + tid] = acc[t];
        } else {
            float acc[8];
#pragma unroll
            for (int t = 0; t < 8; ++t) acc[t] = bias;
#pragma unroll
            for (int j = 0; j < 38; ++j) {
                const float v = __uint_as_float((unsigned)ub[j * 512 + tid] << 16);
#pragma unroll
                for (int t = 0; t < 8; ++t) { if (j - t >= 0 && j - t <= 30) acc[t] += v * wb[j - t]; }
            }
#pragma unroll
            for (int t = 0; t < 8; ++t) cb[t * 512 + tid] = acc[t];
        }
        __syncthreads();
        {
            float g8[8], b8[8]; load8f(lng + c8, g8); load8f(lnb + c8, b8);
            for (int i = 0; i < 4; ++i) {
                const int t = wave * 4 + i;
                if (t < nout) {
                    const f32x4 a = *(const LAS f32x4*)(cb + t * 512 + c8), b = *(const LAS f32x4*)(cb + t * 512 + c8 + 4);
                    float x[8] = {a[0], a[1], a[2], a[3], b[0], b[1], b[2], b[3]};
                    float s = 0.f;
#pragma unroll
                    for (int q = 0; q < 8; ++q) s += x[q];
                    const float mean = wave_sum(s) * (1.f / 512.f);
                    float s2 = 0.f;
#pragma unroll
                    for (int q = 0; q < 8; ++q) { x[q] -= mean; s2 += x[q] * x[q]; }
                    const float rstd = __builtin_amdgcn_rsqf(wave_sum(s2) * (1.f / 512.f) + EPS);
#pragma unroll
                    for (int q = 0; q < 8; ++q) { const float y = x[q] * rstd * g8[q] + b8[q]; x[q] = y * sigmoidf_fast(y); }
                    *(v4u*)(Y + (size_t)(rowbase + t) * D + 512 + c8) = pack8(x);
                }
            }
        }
        if (wave * 4 < nout) {
            float w0[8], w1[8], w2[8]; load8f(cwa + c8, w0); load8f(cwa + 512 + c8, w1); load8f(cwa + 1024 + c8, w2);
            float um2[8], um1[8];
#pragma unroll
            for (int h = 0; h < 2; ++h) {
                const int tt = t0 + wave * 4 - 2 + h; float u[8];
                if (tt >= 0) unpack8(*(const v4u*)(Z + (rowbase + (tt - t0)) * NZ1 + 512 + c8), u);
                else if (samp) load8f(st_a + ((size_t)seq * 2 + (2 + tt)) * 512 + c8, u);
                else {
#pragma unroll
                    for (int q = 0; q < 8; ++q) u[q] = 0.f; }
#pragma unroll
                for (int q = 0; q < 8; ++q) { if (h == 0) um2[q] = u[q]; else um1[q] = u[q]; }
            }
#pragma unroll
            for (int i = 0; i < 4; ++i) {
                const int t = wave * 4 + i; const bf16* zr = Z + (rowbase + t) * NZ1;
                float gbv[8], u0[8], y[8]; unpack8(*(const v4u*)(zr + c8), gbv); unpack8(*(const v4u*)(zr + 512 + c8), u0);
#pragma unroll
                for (int q = 0; q < 8; ++q) y[q] = gbv[q] * (w0[q] * um2[q] + w1[q] * um1[q] + w2[q] * u0[q]);
                *(v4u*)(Y + (size_t)(rowbase + t) * D + c8) = pack8(y);
                const int tt = t0 + t;
                if (!samp) { if (tt >= SEQ - 2) store8f(o_ca_p + ((size_t)seq * 2 + (tt - (SEQ - 2))) * 512 + c8, u0); }
                else if (t >= 6) store8f(o_ca_s + ((size_t)seq * 2 + (t - 6)) * 512 + c8, u0);
#pragma unroll
                for (int q = 0; q < 8; ++q) { um2[q] = um1[q]; um1[q] = u0[q]; }
            }
        }
        __syncthreads();
    }
}

template <int W>
__device__ __forceinline__ void pool_prompt(const bf16* Z, bf16* Y, float* o_pool_p, int seq, int ch, int g, int wave, int lane) {
    const int sub = lane >> 4, c8 = (lane & 15) * 8, col = g * 128 + c8;
    const int tq0 = ch * 128 + 16 * wave + 4 * sub;
    const size_t seqbase = (size_t)seq * SEQ;
    const bf16* zc = Z + seqbase * NZ1 + col;
    v4u rows[W + 3];
#pragma unroll
    for (int r = 0; r < W + 3; ++r) { const int tq = tq0 - (W - 1) + r; rows[r] = (tq >= 0) ? *(const v4u*)(zc + (size_t)tq * NZ1) : (v4u){0u, 0u, 0u, 0u}; }
    float S[8];
#pragma unroll
    for (int q = 0; q < 8; ++q) S[q] = 0.f;
#pragma unroll
    for (int r = 0; r < W; ++r) { float f[8]; unpack8(rows[r], f);
#pragma unroll
        for (int q = 0; q < 8; ++q) S[q] += f[q]; }
#pragma unroll
    for (int i = 0; i < 4; ++i) {
        const int tq = tq0 + i; const float inv = 1.0f / (float)((tq + 1 < W) ? tq + 1 : W);
        float cur[8], dd[8]; unpack8(rows[W - 1 + i], cur);
#pragma unroll
        for (int q = 0; q < 8; ++q) dd[q] = S[q] * inv - cur[q];
        *(v4u*)(Y + (seqbase + tq) * D + col) = pack8(dd);
        if (tq >= SEQ - 15) store8f(o_pool_p + ((size_t)seq * 15 + (tq - (SEQ - 15))) * 512 + col, cur);
        if (i < 3) { float a[8], bb[8]; unpack8(rows[W + i], a); unpack8(rows[i], bb);
#pragma unroll
            for (int q = 0; q < 8; ++q) S[q] += a[q] - bb[q]; }
    }
}
__device__ __forceinline__ int vnt_off(int d, int s) { return d * 128 + ((((s >> 3) ^ ((d >> 3) ^ d)) & 15) << 3) + (s & 7); }

__device__ __forceinline__ void phase_mixer1(const Params& p, LAS unsigned char* lds) {
    int tid_ = threadIdx.x; asm volatile("" : "+v"(tid_)); const int tid = tid_, lane = tid & 63, wave = __builtin_amdgcn_readfirstlane(tid >> 6);
    const bf16* Z = (const bf16*)(p.ws + WS_Z); bf16* Y = (bf16*)(p.ws + WS_YMIX);
    const float* st_pool = p.in[4]; const float* sgw = p.in[17]; const float* sgb = p.in[18]; const float* lng = p.in[19]; const float* lnb = p.in[20];
    const bf16* Wm = (const bf16*)(p.ws + WS_SGUW);
    const float* st1 = (const float*)(p.ws + WS_SS) + (size_t)5 * M; const float* st2 = st1 + M;
    float* o_pl_p = p.out + OUT_PL_P; float* o_pl_s = p.out + OUT_PL_S; float* o_v_s = p.out + OUT_V_S;
    LAS float* stats = (LAS float*)lds; LAS unsigned short* vnT = (LAS unsigned short*)(lds + 1024); LAS float* vns = (LAS float*)(lds + 40960);
    for (int unit = blockIdx.x; unit < 640; unit += gridDim.x) {
        if (unit < 512) {
            const int seq = unit >> 6, ch = (unit >> 2) & 15, g = (unit + 2 * (unit >> 8)) & 3;
            const size_t row0 = (size_t)seq * SEQ + ch * 128;
            if (tid < 128) {
                const float s1 = st1[row0 + tid], s2 = st2[row0 + tid];
                const float mean = s1 * (1.f / 512.f); const float var = fmaxf(s2 * (1.f / 512.f) - mean * mean, 0.f);
                stats[2 * tid] = mean; stats[2 * tid + 1] = __builtin_amdgcn_rsqf(var + EPS);
            }
            __syncthreads();
            {
                const int sub = lane >> 4, c8 = (lane & 15) * 8; float g8[8], b8[8]; load8f(lng + g * 128 + c8, g8); load8f(lnb + g * 128 + c8, b8);
#pragma unroll
                for (int ps = 0; ps < 4; ++ps) {
                    const int t = 16 * wave + 4 * ps + sub; const float mean = stats[2 * t], rstd = stats[2 * t + 1];
                    float x[8]; unpack8(*(const v4u*)(Z + (row0 + t) * NZ1 + 1024 + g * 128 + c8), x);
#pragma unroll
                    for (int q = 0; q < 8; ++q) { const float vn = (x[q] - mean) * rstd * g8[q] + b8[q]; vnT[vnt_off(c8 + q, t)] = (unsigned short)(pk2(vn, 0.f) & 0xffffu); }
                }
            }
            __syncthreads();
            {
                const int fr = lane & 15, fq = lane >> 4, t = 16 * wave + fr;
                f32x4 acc[8];
#pragma unroll
                for (int n = 0; n < 8; ++n) acc[n] = (f32x4){0.f, 0.f, 0.f, 0.f};
                const bf16* wrow = Wm + (size_t)g * 16384 + t * 128;
                const int ksteps = (wave >> 1) + 1;
                for (int k = 0; k < ksteps; ++k) {
                    const bf16x8 bfrag = *(const bf16x8*)(wrow + k * 32 + fq * 8);
#pragma unroll
                    for (int n = 0; n < 8; ++n) { const bf16x8 afrag = *(const LAS bf16x8*)(vnT + vnt_off(n * 16 + fr, k * 32 + fq * 8)); acc[n] = __builtin_amdgcn_mfma_f32_16x16x32_bf16(afrag, bfrag, acc[n], 0, 0, 0); }
                }
                const float bs = sgb[g * 128 + t];
#pragma unroll
                for (int n = 0; n < 8; ++n) {
                    const int col = g * 128 + n * 16 + 4 * fq; const v2u uw = *(const v2u*)(Z + (row0 + t) * NZ1 + 512 + col);
                    const float u0 = __uint_as_float(uw.x << 16), u1 = __uint_as_float(uw.x & 0xffff0000u), u2 = __uint_as_float(uw.y << 16), u3 = __uint_as_float(uw.y & 0xffff0000u);
                    v2u o; o.x = pk2(u0 * (acc[n][0] + bs), u1 * (acc[n][1] + bs)); o.y = pk2(u2 * (acc[n][2] + bs), u3 * (acc[n][3] + bs));
                    *(v2u*)(Y + (row0 + t) * D + 512 + col) = o;
                }
            }
            if (g == 0) pool_prompt<2>(Z, Y, o_pl_p, seq, ch, g, wave, lane);
            else if (g == 1) pool_prompt<4>(Z, Y, o_pl_p, seq, ch, g, wave, lane);
            else if (g == 2) pool_prompt<8>(Z, Y, o_pl_p, seq, ch, g, wave, lane);
            else pool_prompt<16>(Z, Y, o_pl_p, seq, ch, g, wave, lane);
            __syncthreads();
        } else {
            const int b = unit - 512, t = wave, c8 = lane * 8, g = lane >> 4;
            const size_t row = (size_t)MP + b * 8 + t; const bf16* zr = Z + row * NZ1;
            {
                float x[8], g8[8], b8[8]; unpack8(*(const v4u*)(zr + 1024 + c8), x); load8f(lng + c8, g8); load8f(lnb + c8, b8);
                float s = 0.f;
#pragma unroll
                for (int q = 0; q < 8; ++q) s += x[q];
                const float mean = wave_sum(s) * (1.f / 512.f); float s2 = 0.f;
#pragma unroll
                for (int q = 0; q < 8; ++q) { x[q] -= mean; s2 += x[q] * x[q]; }
                const float rstd = __builtin_amdgcn_rsqf(wave_sum(s2) * (1.f / 512.f) + EPS);
#pragma unroll
                for (int q = 0; q < 8; ++q) x[q] = x[q] * rstd * g8[q] + b8[q];
                store8f(o_v_s + ((size_t)b * 8 + t) * 512 + c8, x);
                *(LAS f32x4*)(vns + t * 512 + c8) = (f32x4){x[0], x[1], x[2], x[3]}; *(LAS f32x4*)(vns + t * 512 + c8 + 4) = (f32x4){x[4], x[5], x[6], x[7]};
            }
            __syncthreads();
            {
                float mx[8]; const float bs = sgb[g * 128 + t];
#pragma unroll
                for (int q = 0; q < 8; ++q) mx[q] = bs;
                for (int s = 0; s <= t; ++s) {
                    const float w = sgw[(size_t)g * 16384 + t * 128 + s];
                    const f32x4 a = *(const LAS f32x4*)(vns + s * 512 + c8), c = *(const LAS f32x4*)(vns + s * 512 + c8 + 4);
                    mx[0] += w * a[0]; mx[1] += w * a[1]; mx[2] += w * a[2]; mx[3] += w * a[3]; mx[4] += w * c[0]; mx[5] += w * c[1]; mx[6] += w * c[2]; mx[7] += w * c[3];
                }
                float u[8]; unpack8(*(const v4u*)(zr + 512 + c8), u);
#pragma unroll
                for (int q = 0; q < 8; ++q) u[q] *= mx[q];
                *(v4u*)(Y + row * D + 512 + c8) = pack8(u);
            }
            {
                const int W = 2 << g; float S[8];
#pragma unroll
                for (int q = 0; q < 8; ++q) S[q] = 0.f;
#pragma nounroll
                for (int i = 0; i < W; ++i) {
                    const int tt = t - i; float f[8];
                    if (tt >= 0) unpack8(*(const v4u*)(Z + ((size_t)MP + b * 8 + tt) * NZ1 + c8), f); else load8f(st_pool + ((size_t)b * 15 + 15 + tt) * 512 + c8, f);
#pragma unroll
                    for (int q = 0; q < 8; ++q) S[q] += f[q];
                }
                float cur[8]; unpack8(*(const v4u*)(zr + c8), cur); const float inv = 1.0f / (float)W;
#pragma unroll
                for (int q = 0; q < 8; ++q) S[q] = S[q] * inv - cur[q];
                *(v4u*)(Y + row * D + c8) = pack8(S);
                for (int j = wave; j < 15; j += 8) {
                    float f[8];
                    if (j < 7) load8f(st_pool + ((size_t)b * 15 + 8 + j) * 512 + c8, f); else unpack8(*(const v4u*)(Z + ((size_t)MP + b * 8 + (j - 7)) * NZ1 + c8), f);
                    store8f(o_pl_s + ((size_t)b * 15 + j) * 512 + c8, f);
                }
            }
            __syncthreads();
        }
    }
}

template <bool FINAL>
__device__ __forceinline__ void sample_fixup(const Params& p, int S, float* ss_s, const float* gf) {
    int tid_ = threadIdx.x; asm volatile("" : "+v"(tid_)); const int tid = tid_, lane = tid & 63, wave = tid >> 6;
    const int gw = blockIdx.x * 8 + wave, NGW = gridDim.x * 8;
    const float* part = (const float*)(p.ws + WS_PART); bf16* XB = (bf16*)(p.ws + WS_XB) + (size_t)MP * D; float* xo = p.out + (size_t)MP * D;
    for (int r = gw; r < MS; r += NGW) {
        f32x4 v[4];
        unsigned long long* o8 = (unsigned long long*)(XB + (size_t)r * D) + lane;
#pragma unroll
        for (int j = 0; j < 4; ++j) { const unsigned long long w = o8[64 * j]; const unsigned lo = (unsigned)w, hi = (unsigned)(w >> 32);
            v[j] = (f32x4){__uint_as_float(lo << 16), __uint_as_float(lo & 0xffff0000u), __uint_as_float(hi << 16), __uint_as_float(hi & 0xffff0000u)}; }
        for (int sp = 0; sp < S; ++sp) {
            const f32x4* pr = (const f32x4*)(part + ((size_t)sp * MS + r) * D) + lane;
#pragma unroll
            for (int j = 0; j < 4; ++j) v[j] += pr[64 * j];
        }
        float s = 0.f;
#pragma unroll
        for (int j = 0; j < 4; ++j) s += (v[j][0] * v[j][0] + v[j][1] * v[j][1]) + (v[j][2] * v[j][2] + v[j][3] * v[j][3]);
        s = wave_sum(s);
        if (!FINAL) {
#pragma unroll
            for (int j = 0; j < 4; ++j) o8[64 * j] = (unsigned long long)pk2(v[j][0], v[j][1]) | ((unsigned long long)pk2(v[j][2], v[j][3]) << 32);
            if (lane == 0) ss_s[r] = s;
        } else {
            const float rs = __builtin_amdgcn_rsqf(s * (1.f / 1024.f) + EPS);
#pragma unroll
            for (int j = 0; j < 4; ++j) *((f32x4*)(xo + (size_t)r * D) + lane + 64 * j) = v[j] * rs * *((const f32x4*)gf + lane + 64 * j);
        }
    }
}
__device__ __forceinline__ void phase_final(const Params& p) {
    int tid_ = threadIdx.x; asm volatile("" : "+v"(tid_)); const int tid = tid_, lane = tid & 63, wave = tid >> 6;
    const int gw = blockIdx.x * 8 + wave, NGW = gridDim.x * 8;
    const float* ss4 = (const float*)(p.ws + WS_SS) + 4 * (size_t)M; const float* gf = p.in[24];
    f32x4 g4[4];
#pragma unroll
    for (int j = 0; j < 4; ++j) g4[j] = *((const f32x4*)gf + lane + 64 * j);
    const bf16* XB = (const bf16*)(p.ws + WS_XB);
    for (int m0 = gw; m0 < MP; m0 += 8 * NGW) {
        unsigned long long w[8][4]; float ssv[8];
#pragma unroll
        for (int k = 0; k < 8; ++k) { const int m = m0 + k * NGW;
            if (m < MP) { ssv[k] = ss4[m]; const unsigned long long* x8 = (const unsigned long long*)(XB + (size_t)m * D) + lane;
#pragma unroll
                for (int j = 0; j < 4; ++j) w[k][j] = x8[64 * j]; } }
#pragma unroll
        for (int k = 0; k < 8; ++k) { const int m = m0 + k * NGW;
            if (m < MP) { const float rs = __builtin_amdgcn_rsqf(ssv[k] * (1.f / 1024.f) + EPS); f32x4* xr = (f32x4*)(p.out + (size_t)m * D) + lane;
#pragma unroll
                for (int j = 0; j < 4; ++j) { const unsigned lo = (unsigned)w[k][j], hi = (unsigned)(w[k][j] >> 32);
                    const f32x4 v = (f32x4){__uint_as_float(lo << 16), __uint_as_float(lo & 0xffff0000u), __uint_as_float(hi << 16), __uint_as_float(hi & 0xffff0000u)};
                    xr[64 * j] = v * rs * g4[j]; } } }
    }
    sample_fixup<true>(p, S_FFN2, nullptr, gf);
}

template <int layer>
__device__ __forceinline__ void run_layer(const Params& p, LAS unsigned char* lds, const XcdBarrier& xbar, const int lo, const int hi) {
#define IN(k) (lo <= (k) && (k) < hi)
#define SEAM(k) do { if (lo <= (k) && (k) + 1 < hi) xcd_barrier(xbar); } while (0)
    unsigned char* ws = p.ws;
    float* ssb = (float*)(ws + WS_SS);
    bf16* XB = (bf16*)(ws + WS_XB); bf16* Zb = (bf16*)(ws + WS_Z); bf16* Yb = (bf16*)(ws + WS_YMIX); bf16* Hb = (bf16*)(ws + WS_H);
        const int pb = 1 + 7 * layer;
        const bf16* Win = (const bf16*)(ws + (layer ? WS_WIN1 : WS_WIN0)); const bf16* Wout = (const bf16*)(ws + (layer ? WS_WOUT1 : WS_WOUT0));
        const bf16* W1 = (const bf16*)(ws + (layer ? WS_W1_1 : WS_W1_0)); const bf16* W2 = (const bf16*)(ws + (layer ? WS_W2_1 : WS_W2_0));
        const int NZ = layer ? NZ1 : NZ0;
        float* ss_in = ssb + (size_t)(2 * layer) * M; float* ss_mid = ss_in + M; float* ss_out = ss_mid + M;
        float* part = (float*)(ws + WS_PART);
        if (IN(pb)) {
            pg8::Gemm g{XB, Win, M, NZ, D, D, 128, (size_t)256 * D * 2, 0}; pg8::StaticOrder S; S.init(M, NZ, D, gridDim.x, blockIdx.x);
            if constexpr (layer == 0) { pg8::EpiGate E{Zb, ss_in}; pg8::gemm_phase<pg8::EpiGate, pg8::StaticOrder, true, true>(lds, g, S, E); }
            else { pg8::EpiScaleBf16<0, false, true> E{Zb, NZ, ss_in, ssb + (size_t)5 * M, ssb + (size_t)6 * M, 4};
                pg8::gemm_phase<pg8::EpiScaleBf16<0, false, true>, pg8::StaticOrder, true, true>(lds, g, S, E); }
            if (layer == 0) {
                const int G = gridDim.x, nu = (M / 256) * (NZ0 / 256), rounds = (nu + G - 1) / G; int full = nu - (rounds - 1) * G; if (full >= G) full = 0;
                phase_prologue_late<1>(p, lds, full);
            } else {
                const int G = gridDim.x, nu = (M / 256) * (NZ1 / 256), rounds = (nu + G - 1) / G; int full = nu - (rounds - 1) * G; if (full >= G) full = 0;
                phase_prologue_late<3>(p, lds, full);
            }
        }
        SEAM(pb);
        if (IN(pb + 1)) { if (layer == 0) phase_mixer0(p, lds); else phase_mixer1(p, lds); }
        SEAM(pb + 1);
        if (IN(pb + 2)) {
            pg8::Gemm g{Yb, Wout, M, D, D, D, 128, (size_t)256 * D * 2, 0}; pg8::ResidOrder S; S.init(D, S_OUT, gridDim.x, blockIdx.x);
            pg8::EpiResid<false> E{XB, nullptr, ss_mid, part, nullptr, nullptr};
            pg8::gemm_phase<pg8::EpiResid<false>, pg8::ResidOrder, true, true>(lds, g, S, E);
        }
        SEAM(pb + 2);
        if (IN(pb + 4)) {
            {
                sample_fixup<false>(p, S_OUT, ss_mid + MP, nullptr);
                asm volatile("s_waitcnt vmcnt(0)" ::: "memory");
                __syncthreads();
                if (threadIdx.x == 0) {
                    __builtin_amdgcn_fence(__ATOMIC_RELEASE, "agent");
                    asm volatile("s_waitcnt vmcnt(0)" ::: "memory");
                    __hip_atomic_fetch_add((unsigned*)(ws + WS_BAR + 16384 + 4096 * layer), 1u, __ATOMIC_RELAXED, __HIP_MEMORY_SCOPE_AGENT);
                }
            }
            pg8::Gemm g{XB, W1, M, FF, D, D, 128, (size_t)256 * D * 2, 0};
            pg8::EpiScaleBf16<1, true> E{Hb, FF, ss_mid, nullptr, nullptr, 0};
            if constexpr (layer == 0) {
                pg8::FixOrder S; S.init(M, FF, D, gridDim.x, blockIdx.x); S.cnt = (const unsigned*)(ws + WS_BAR + 16384 + 4096 * layer); S.need = gridDim.x;
                pg8::gemm_phase<pg8::EpiScaleBf16<1, true>, pg8::FixOrder, true, true>(lds, g, S, E);
            } else {
                pg8::QuarterOrder S; S.initq(FF, D, gridDim.x, blockIdx.x); S.cnt = (const unsigned*)(ws + WS_BAR + 16384 + 4096 * layer); S.need = gridDim.x;
                pg8::gemm_phase<pg8::EpiScaleBf16<1, true>, pg8::QuarterOrder, true, true>(lds, g, S, E);
            }
            if (layer == 0) {
                const int G = gridDim.x, nu = (M / 256) * (FF / 256), rounds = (nu + G - 1) / G; int full = nu - (rounds - 1) * G; if (full >= G) full = 0;
                phase_prologue_late<2>(p, lds, full);
            }
        }
        SEAM(pb + 4);
        if (IN(pb + 5)) {
            pg8::Gemm g{Hb, W2, M, D, FF, 32, 32768, (size_t)64 * 32768, 1}; pg8::ResidOrder S; S.init(FF, S_FFN2, gridDim.x, blockIdx.x);
            pg8::EpiResid<false> E{XB, nullptr, ss_out, part, nullptr, nullptr};
            pg8::gemm_phase<pg8::EpiResid<false>, pg8::ResidOrder, true, true>(lds, g, S, E);
        }
        SEAM(pb + 5);
        if (layer == 0) { if (IN(pb + 6)) sample_fixup<false>(p, S_FFN2, ss_out + MP, nullptr); SEAM(pb + 6); }
#undef IN
#undef SEAM
}
__global__ void __launch_bounds__(512, 2) mega_fwd(Params p) {
    extern __shared__ __attribute__((aligned(16))) unsigned char lds_raw[];
    LAS unsigned char* lds = (LAS unsigned char*)lds_raw;
    cg::grid_group grid = cg::this_grid();
    const int lo = p.ph_lo, hi = p.ph_hi;
    volatile LAS unsigned* bst = (volatile LAS unsigned*)(lds + LDS_BYTES - 16);
    if (threadIdx.x < 2) bst[threadIdx.x] = 0u;
    __syncthreads();
    XcdBarrier xbar = xcd_barrier_post((unsigned*)(p.ws + WS_BAR), bst);
#define IN(k) (lo <= (k) && (k) < hi)
#define SEAM(k) do { if (lo <= (k) && (k) + 1 < hi) xcd_barrier(xbar); } while (0)
    unsigned char* ws = p.ws;
    float* ssb = (float*)(ws + WS_SS);
    bf16* XB = (bf16*)(ws + WS_XB); bf16* Zb = (bf16*)(ws + WS_Z); bf16* Yb = (bf16*)(ws + WS_YMIX); bf16* Hb = (bf16*)(ws + WS_H);
    if (p.ph_hi > 1000) grid.sync();
    if (IN(0)) phase_prologue(p, lds);
    SEAM(0);
    run_layer<0>(p, lds, xbar, lo, hi);
    run_layer<1>(p, lds, xbar, lo, hi);
    if (IN(14)) phase_final(p);
#undef IN
#undef SEAM
}

#ifndef N_LAUNCH_MODE
#define N_LAUNCH_MODE 1
#endif
extern "C" void kernel_launch(void* const* d_in, const int* in_sizes, int n_in, void* d_out, int out_size, void* d_ws, size_t ws_size, hipStream_t stream) {
    static int grid = 0;
    if (grid == 0) {
        if (n_in != 25 || out_size != (int)OUT_TOTAL || ws_size < WS_END) { fprintf(stderr, "kernel_launch: unexpected shapes (n_in %d out %d ws %zu)\n", n_in, out_size, ws_size); grid = -1; return; }
        int dev = 0, cus = 0, per_cu = 0;
        if (hipGetDevice(&dev) != hipSuccess || hipDeviceGetAttribute(&cus, hipDeviceAttributeMultiprocessorCount, dev) != hipSuccess) { grid = -1; return; }
        if (hipFuncSetAttribute((const void*)mega_fwd, hipFuncAttributeMaxDynamicSharedMemorySize, LDS_BYTES) != hipSuccess) { fprintf(stderr, "kernel_launch: hipFuncSetAttribute failed\n"); grid = -1; return; }
        if (hipOccupancyMaxActiveBlocksPerMultiprocessor(&per_cu, (const void*)mega_fwd, 512, LDS_BYTES) != hipSuccess || per_cu < 1) { fprintf(stderr, "kernel_launch: occupancy query says %d\n", per_cu); (void)hipGetLastError(); per_cu = 1; }
        grid = cus * 1;
        if (cus < 256) fprintf(stderr, "kernel_launch: built for a 256-CU device (fused final norm exchange); %d CUs will give wrong rows\n", cus);
        if (grid > 256) grid = 256;
        if (grid > cus * per_cu) grid = cus * per_cu;
    }
    if (grid < 0) return;
    Params p{};
    for (int i = 0; i < 25; ++i) p.in[i] = (const float*)d_in[i];
    p.out = (float*)d_out; p.ws = (unsigned char*)d_ws;
#if N_LAUNCH_MODE == 1
    if (hipMemsetAsync((unsigned char*)d_ws + WS_BAR, 0, 32768, stream) != hipSuccess) { fprintf(stderr, "kernel_launch: memset failed\n"); return; }
    p.ph_lo = 0; p.ph_hi = 15;
    void* args[] = {&p};
    hipError_t e = hipLaunchCooperativeKernel((const void*)mega_fwd, dim3(grid), dim3(512), args, LDS_BYTES, stream);
    if (e != hipSuccess) fprintf(stderr, "cooperative launch failed: %s (grid %d)\n", hipGetErrorString(e), grid);
#else
    for (int ph = 0; ph < 15; ++ph) { p.ph_lo = ph; p.ph_hi = ph + 1; hipLaunchKernelGGL(mega_fwd, dim3(grid), dim3(512), LDS_BYTES, stream, p); }
#endif
}
```

```cpp
#include <hip/hip_runtime.h>
#include <hip/hip_cooperative_groups.h>
#include <cstdio>
#include <cstdint>
namespace cg = cooperative_groups;
namespace pg8 {
#define PG8_LAS __attribute__((address_space(3)))
typedef unsigned short bf16_t;
typedef short bf16x8 __attribute__((ext_vector_type(8)));
typedef float f32x4 __attribute__((ext_vector_type(4)));
typedef unsigned u32x4 __attribute__((ext_vector_type(4)));
constexpr int BM = 256, BK = 64, HALF = 128, HTB = HALF * BK * 2  , STAGE_BYTES = 8 * HTB, NXCD = 8, WGM = 8;

__host__ __device__ __forceinline__ int lds_byte(int r, int c) { const int st = (r >> 4) * 2 + (c >> 5), rr = r & 15, cc = c & 31, ob = rr * 64 + cc * 2; return st * 1024 + (ob ^ (((ob >> 9) & 1) << 5)); }
__host__ __device__ __forceinline__ void stage_rc(int b, int& R, int& C) { const int st = b / 1024, sb = b % 1024, swz = sb ^ (((sb >> 9) & 1) << 5); R = (st >> 1) * 16 + swz / 64; C = (st & 1) * 32 + (swz % 64) / 2; }
__host__ __device__ __forceinline__ int perm32(int rho) { const int n = rho >> 4, i = rho & 15; return 8 * (i >> 2) + 4 * n + (i & 3); }

struct Unit { int pm, pn, k0, nt, sp, qa, qb; };
struct Gemm { const bf16_t* A; const bf16_t* Bt; int M, N, K, lda; size_t kstepA, tstepA; int asub; };

struct StaticOrder {
    int nM, nN, nwg, G, c, ntK;
    __host__ __device__ __forceinline__ void init(int M, int N, int K, int G_, int c_) { nM = M / BM; nN = N / BM; nwg = nM * nN; G = G_; c = c_; ntK = K / BK; }
    __host__ __device__ __forceinline__ void map(int L, Unit& u) const {
        int wgid = L; { const int q = nwg / NXCD, r = nwg % NXCD, xcd = wgid % NXCD, off = wgid / NXCD; wgid = (xcd < r ? xcd * (q + 1) : r * (q + 1) + (xcd - r) * q) + off; }
        const int nig = WGM * nN, gid = wgid / nig, fm = gid * WGM, gsz = (nM - fm) < WGM ? (nM - fm) : WGM;
        u.pm = fm + ((wgid % nig) % gsz); u.pn = (wgid % nig) / gsz; u.k0 = 0; u.nt = ntK; u.sp = -1; u.qa = -1; u.qb = -1;
    }
    __host__ __device__ __forceinline__ bool next(int i, Unit& u) const { const long L = (long)i * G + c; if (L >= nwg) return false; map((int)L, u); return true; }
    __device__ __forceinline__ void a_ready(const Unit&) const {}
    __device__ __forceinline__ void done(const Unit&) const {}
};
struct FixOrder : StaticOrder {
    const unsigned* cnt; unsigned need;
    __device__ __forceinline__ void a_ready(const Unit& u) const {
        if (u.pm < 64) return;
        if (threadIdx.x < 64) {
            unsigned spins = 0;
            while ((unsigned)__builtin_amdgcn_readfirstlane(__hip_atomic_load(cnt, __ATOMIC_RELAXED, __HIP_MEMORY_SCOPE_AGENT)) < need && ++spins < (1u << 22)) __builtin_amdgcn_s_sleep(2);
            __builtin_amdgcn_fence(__ATOMIC_ACQUIRE, "agent");
            asm volatile("s_waitcnt vmcnt(0)" ::: "memory");
        }
        asm volatile("" ::: "memory"); __builtin_amdgcn_s_barrier(); asm volatile("" ::: "memory");
    }
};
struct QuarterOrder : FixOrder {
    StaticOrder sp_; int nq;
    __host__ __device__ __forceinline__ void initq(int N, int K, int G_, int c_) { sp_.init(16384, N, K, G_, c_); init(17408, N, K, G_, c_); nq = 4 * 4 * (N / BM); }
    __host__ __device__ __forceinline__ bool next(int i, Unit& u) const {
        const int L = i * sp_.G + sp_.c; const bool isp = L < sp_.nwg; const int j = isp ? 0 : L - sp_.nwg;
        Unit a; sp_.map(isp ? L : 0, a);
        const int s = j >> 2;
        u.pm = isp ? a.pm : 64 + s / sp_.nN; u.pn = isp ? a.pn : s % sp_.nN; u.k0 = 0; u.nt = a.nt; u.sp = -1; u.qa = isp ? -1 : ((j >> 1) & 1); u.qb = isp ? -1 : (j & 1);
        return isp || j < nq;
    }
};
struct ResidOrder {
    StaticOrder so; int S, ntS;
    __host__ __device__ __forceinline__ void init(int K, int S_, int G_, int c_) { so.init(16384, 1024, K, G_, c_); S = S_; ntS = K / BK / S_; }
    __host__ __device__ __forceinline__ bool next(int i, Unit& u) const {
        const int ii = (so.c < 16 * S && so.G >= so.nwg && i < 2) ? 1 - i : i;
        const int L = ii * so.G + so.c; const bool isp = L < so.nwg; const int j = isp ? 0 : L - so.nwg;
        Unit a; so.map(isp ? L : 0, a);
        const int q = j / S, sp = j - q * S;
        u.pm = isp ? a.pm : 64 + (q >> 2); u.pn = isp ? a.pn : (q & 3); u.sp = isp ? -1 : sp; u.nt = isp ? a.nt : ntS; u.k0 = isp ? 0 : sp * ntS * BK; u.qa = -1; u.qb = -1;
        return isp || j < 16 * S;
    }
    __device__ __forceinline__ void a_ready(const Unit&) const {}
    __device__ __forceinline__ void done(const Unit&) const {}
};
__device__ __forceinline__ unsigned cvt_pk_bf16(float lo, float hi) { unsigned r; asm volatile("v_cvt_pk_bf16_f32 %0, %1, %2" : "=v"(r) : "v"(lo), "v"(hi)); return r; }
typedef float f32x2 __attribute__((ext_vector_type(2)));
constexpr float RMS_EPS = 1e-6f;
template <int ACT, bool BLK = false, bool STATS = false> struct EpiScaleBf16 {
    static constexpr bool PERM = true, AFTER_DRAIN = false;
    bf16_t* O; int ldc; const float* ss; float* st1; float* st2; int stat_pn0;
    __device__ __forceinline__ void operator()(const f32x4 (&acc)[2][2][4][2], const Unit& u, int wr, int wc, int fr, int fq) const {
        const bool whole = u.qa < 0;
        const int row0 = u.pm * BM + wr * 64 + fr + (u.qa > 0 ? HALF : 0), col0 = u.pn * BM + wc * 32 + 8 * fq + (u.qb > 0 ? HALF : 0);
        float rsv[2][4];
#pragma unroll
        for (int ai = 0; ai < 2; ++ai)
#pragma unroll
            for (int m = 0; m < 4; ++m) rsv[ai][m] = ss[row0 + ai * HALF + m * 16];
#pragma unroll
        for (int ai = 0; ai < 2; ++ai)
#pragma unroll
            for (int m = 0; m < 4; ++m) rsv[ai][m] = __builtin_amdgcn_rsqf(rsv[ai][m] * (1.0f / 1024.0f) + RMS_EPS);
#pragma unroll
        for (int ai = 0; ai < 2; ++ai)
#pragma unroll
            for (int m = 0; m < 4; ++m) {
                if (ai == 1 && !whole) continue;
                const int row = row0 + ai * HALF + m * 16;
                const float rs = rsv[ai][m];
                float s1 = 0.f, s2 = 0.f;
                bf16_t* rowp = BLK ? O + ((size_t)u.pm * (ldc >> 6) + (size_t)(col0 >> 6)) * 16384 + (size_t)((col0 >> 5) & 1) * 8192 + (size_t)(row - u.pm * BM) * 32 + (col0 & 31) : O + (size_t)row * ldc + col0;
#pragma unroll
                for (int bj = 0; bj < 2; ++bj) {
                    if (bj == 1 && !whole) continue;
                    f32x4 v0 = acc[ai][bj][m][0] * rs, v1 = acc[ai][bj][m][1] * rs;
                    if (ACT == 1) {
#pragma unroll
                        for (int j = 0; j < 4; ++j) { const float a = fmaxf(v0[j], 0.f), b = fmaxf(v1[j], 0.f); v0[j] = a * a; v1[j] = b * b; }
                    }
                    u32x4 w; w.x = cvt_pk_bf16(v0[0], v0[1]); w.y = cvt_pk_bf16(v0[2], v0[3]); w.z = cvt_pk_bf16(v1[0], v1[1]); w.w = cvt_pk_bf16(v1[2], v1[3]);
                    *(u32x4*)(rowp + (BLK ? bj * 2 * 16384 : bj * HALF)) = w;
                    if (STATS) { s1 += (v0[0] + v0[1]) + (v0[2] + v0[3]) + (v1[0] + v1[1]) + (v1[2] + v1[3]);
                        s2 += (v0[0] * v0[0] + v0[1] * v0[1]) + (v0[2] * v0[2] + v0[3] * v0[3]) + (v1[0] * v1[0] + v1[1] * v1[1]) + (v1[2] * v1[2] + v1[3] * v1[3]); }
                }
                if (STATS && u.pn >= stat_pn0) {
                    s1 += __shfl_xor(s1, 16); s1 += __shfl_xor(s1, 32); s2 += __shfl_xor(s2, 16); s2 += __shfl_xor(s2, 32);
                    if (fq == 0) { atomicAdd(st1 + row, s1); atomicAdd(st2 + row, s2); }
                }
            }
    }
};
struct EpiGate {
    static constexpr bool PERM = true, AFTER_DRAIN = false;
    bf16_t* O; const float* ss;
    __device__ __forceinline__ void operator()(const f32x4 (&acc)[2][2][4][2], const Unit& u, int wr, int wc, int fr, int fq) const {
        const int row0 = u.pm * BM + wr * 64 + fr, wcol = wc * 32 + 8 * fq;
        float rsv[2][4];
#pragma unroll
        for (int ai = 0; ai < 2; ++ai)
#pragma unroll
            for (int m = 0; m < 4; ++m) rsv[ai][m] = ss[row0 + ai * HALF + m * 16];
#pragma unroll
        for (int ai = 0; ai < 2; ++ai)
#pragma unroll
            for (int m = 0; m < 4; ++m) rsv[ai][m] = __builtin_amdgcn_rsqf(rsv[ai][m] * (1.0f / 1024.0f) + RMS_EPS);
#pragma unroll
        for (int ai = 0; ai < 2; ++ai)
#pragma unroll
            for (int m = 0; m < 4; ++m) {
                const int row = row0 + ai * HALF + m * 16;
                const float rs = rsv[ai][m];
                bf16_t* rowp = O + (size_t)row * 1536;
                const f32x4 a0 = acc[ai][0][m][0] * rs, a1 = acc[ai][0][m][1] * rs, b0 = acc[ai][1][m][0] * rs, b1 = acc[ai][1][m][1] * rs;
                if (u.pn < 2) {
                    u32x4 w; w.x = cvt_pk_bf16(a0[0], a0[1]); w.y = cvt_pk_bf16(a0[2], a0[3]); w.z = cvt_pk_bf16(a1[0], a1[1]); w.w = cvt_pk_bf16(a1[2], a1[3]);
                    *(u32x4*)(rowp + u.pn * 256 + wcol) = w;
                    w.x = cvt_pk_bf16(b0[0], b0[1]); w.y = cvt_pk_bf16(b0[2], b0[3]); w.z = cvt_pk_bf16(b1[0], b1[1]); w.w = cvt_pk_bf16(b1[2], b1[3]);
                    *(u32x4*)(rowp + u.pn * 256 + 128 + wcol) = w;
                } else {
                    f32x4 r0, r1;
                    if (u.pn < 6) { r0 = a0 * b0; r1 = a1 * b1; }
                    else {
#pragma unroll
                        for (int j = 0; j < 4; ++j) { r0[j] = a0[j] * __builtin_amdgcn_rcpf(1.0f + __expf(-b0[j])); r1[j] = a1[j] * __builtin_amdgcn_rcpf(1.0f + __expf(-b1[j])); }
                    }
                    u32x4 w; w.x = cvt_pk_bf16(r0[0], r0[1]); w.y = cvt_pk_bf16(r0[2], r0[3]); w.z = cvt_pk_bf16(r1[0], r1[1]); w.w = cvt_pk_bf16(r1[2], r1[3]);
                    *(u32x4*)(rowp + (u.pn < 6 ? 512 + (u.pn - 2) * 128 : 1024 + (u.pn - 6) * 128) + wcol) = w;
                }
            }
    }
};
template <bool FUSE> struct EpiResid {
    static constexpr bool PERM = true, AFTER_DRAIN = false;
    bf16_t* xb; float* xout; float* ss; float* part;
    const float* gfin; unsigned* cnt;
    __device__ __forceinline__ void operator()(const f32x4 (&acc)[2][2][4][2], const Unit& u, int wr, int wc, int fr, int fq) const {
        const int row0 = u.pm * BM + wr * 64 + fr, col0 = u.pn * BM + wc * 32 + 8 * fq;
        if (u.sp >= 0) {
            bf16_t* pb = (bf16_t*)part + ((size_t)u.sp * 1024 + (row0 - 16384)) * 1024 + col0;
#pragma unroll
            for (int ai = 0; ai < 2; ++ai)
#pragma unroll
                for (int m = 0; m < 4; ++m)
#pragma unroll
                    for (int bj = 0; bj < 2; ++bj) { const f32x4 v0 = acc[ai][bj][m][0], v1 = acc[ai][bj][m][1];
                        u32x4 w; w.x = cvt_pk_bf16(v0[0], v0[1]); w.y = cvt_pk_bf16(v0[2], v0[3]); w.z = cvt_pk_bf16(v1[0], v1[1]); w.w = cvt_pk_bf16(v1[2], v1[3]);
                        *(u32x4*)(pb + (size_t)(ai * HALF + m * 16) * 1024 + bj * HALF) = w; }
            return;
        }
        if (FUSE) {
            f32x4 (&a)[2][2][4][2] = const_cast<f32x4 (&)[2][2][4][2]>(acc);
#pragma unroll
            for (int ai = 0; ai < 2; ++ai)
#pragma unroll
                for (int m = 0; m < 4; ++m) {
                    const int row = row0 + ai * HALF + m * 16;
                    const bf16_t* xr = xb + (size_t)row * 1024 + col0;
                    float part_ss = 0.f;
#pragma unroll
                    for (int bj = 0; bj < 2; ++bj) {
                        const u32x4 o = *(const u32x4*)(xr + bj * HALF);
                        f32x4 v0 = a[ai][bj][m][0], v1 = a[ai][bj][m][1];
                        v0[0] += __uint_as_float(o.x << 16); v0[1] += __uint_as_float(o.x & 0xffff0000u); v0[2] += __uint_as_float(o.y << 16); v0[3] += __uint_as_float(o.y & 0xffff0000u);
                        v1[0] += __uint_as_float(o.z << 16); v1[1] += __uint_as_float(o.z & 0xffff0000u); v1[2] += __uint_as_float(o.w << 16); v1[3] += __uint_as_float(o.w & 0xffff0000u);
                        a[ai][bj][m][0] = v0; a[ai][bj][m][1] = v1;
                        part_ss += (v0[0] * v0[0] + v0[1] * v0[1]) + (v0[2] * v0[2] + v0[3] * v0[3]) + (v1[0] * v1[0] + v1[1] * v1[1]) + (v1[2] * v1[2] + v1[3] * v1[3]);
                    }
                    part_ss += __shfl_xor(part_ss, 16); part_ss += __shfl_xor(part_ss, 32);
                    if (fq == 0) { const float old = atomicAdd(ss + row, part_ss); asm volatile("" :: "v"(old)); }
                    __builtin_amdgcn_sched_barrier(0);
                }
            asm volatile("s_waitcnt vmcnt(0)" ::: "memory");
            __syncthreads();
            if (threadIdx.x == 0) {
                unsigned* c = cnt + 64 * u.pm;
                __hip_atomic_fetch_add(c, 1u, __ATOMIC_RELAXED, __HIP_MEMORY_SCOPE_AGENT);
                unsigned spins = 0;
                while (__hip_atomic_load(c, __ATOMIC_RELAXED, __HIP_MEMORY_SCOPE_AGENT) < 4u && ++spins < (1u << 22)) __builtin_amdgcn_s_sleep(2);
            }
            __syncthreads();
#pragma unroll
            for (int ai = 0; ai < 2; ++ai)
#pragma unroll
                for (int m = 0; m < 4; ++m) {
                    const int row = row0 + ai * HALF + m * 16;
                    const float ssv = atomicAdd(ss + row, 0.0f);
                    const float rs = __builtin_amdgcn_rsqf(ssv * (1.0f / 1024.0f) + RMS_EPS);
#pragma unroll
                    for (int bj = 0; bj < 2; ++bj) {
                        const f32x4 g0 = *(const f32x4*)(gfin + col0 + bj * HALF), g1 = *(const f32x4*)(gfin + col0 + bj * HALF + 4);
                        float* xo = xout + (size_t)row * 1024 + col0 + bj * HALF;
                        *(f32x4*)xo = a[ai][bj][m][0] * rs * g0; *(f32x4*)(xo + 4) = a[ai][bj][m][1] * rs * g1;
                    }
                    __builtin_amdgcn_sched_barrier(0);
                }
            return;
        }
        u32x4 xo[2][4][2];
#pragma unroll
        for (int ai = 0; ai < 2; ++ai)
#pragma unroll
            for (int m = 0; m < 4; ++m)
#pragma unroll
                for (int bj = 0; bj < 2; ++bj) xo[ai][m][bj] = *(const u32x4*)(xb + (size_t)(row0 + ai * HALF + m * 16) * 1024 + col0 + bj * HALF);
#pragma unroll
        for (int ai = 0; ai < 2; ++ai)
#pragma unroll
            for (int m = 0; m < 4; ++m) {
                const int row = row0 + ai * HALF + m * 16;
                bf16_t* xr = xb + (size_t)row * 1024 + col0;
                float part_ss = 0.f;
#pragma unroll
                for (int bj = 0; bj < 2; ++bj) {
                    const u32x4 o = xo[ai][m][bj];
                    f32x4 v0 = acc[ai][bj][m][0], v1 = acc[ai][bj][m][1];
                    v0[0] += __uint_as_float(o.x << 16); v0[1] += __uint_as_float(o.x & 0xffff0000u); v0[2] += __uint_as_float(o.y << 16); v0[3] += __uint_as_float(o.y & 0xffff0000u);
                    v1[0] += __uint_as_float(o.z << 16); v1[1] += __uint_as_float(o.z & 0xffff0000u); v1[2] += __uint_as_float(o.w << 16); v1[3] += __uint_as_float(o.w & 0xffff0000u);
                    if (xout) { float* xo = xout + (size_t)row * 1024 + col0 + bj * HALF; *(f32x4*)xo = v0; *(f32x4*)(xo + 4) = v1; }
                    else { u32x4 w; w.x = cvt_pk_bf16(v0[0], v0[1]); w.y = cvt_pk_bf16(v0[2], v0[3]); w.z = cvt_pk_bf16(v1[0], v1[1]); w.w = cvt_pk_bf16(v1[2], v1[3]); *(u32x4*)(xr + bj * HALF) = w; }
                    part_ss += (v0[0] * v0[0] + v0[1] * v0[1]) + (v0[2] * v0[2] + v0[3] * v0[3]) + (v1[0] * v1[0] + v1[1] * v1[1]) + (v1[2] * v1[2] + v1[3] * v1[3]);
                }
                part_ss += __shfl_xor(part_ss, 16); part_ss += __shfl_xor(part_ss, 32);
                if (fq == 0) atomicAdd(ss + row, part_ss);
            }
    }
};
template <class Epi, class Sched, bool ALIGN_EPI = false, bool SP2 = false>
__device__ __forceinline__ void gemm_phase(PG8_LAS unsigned char* lds, const Gemm g, const Sched& S, const Epi& E) {
    int tid_ = threadIdx.x; asm volatile("" : "+v"(tid_));
    const int tid = tid_, wid = __builtin_amdgcn_readfirstlane(tid >> 6), lane = tid & 63, wr = wid >> 2, wc = wid & 3, fr = lane & 15, fq = lane >> 4;
    const int K = g.K;
    unsigned voffA[2], voffB[2];
#pragma unroll
    for (int i = 0; i < 2; ++i) { int R, C; stage_rc(tid * 16 + i * 8192, R, C); const int Rb = Epi::PERM ? ((R & ~31) + perm32(R & 31)) : R;
        voffA[i] = g.asub ? (unsigned)((C >> 5) * 16384 + (R * 32 + (C & 31)) * 2) : (unsigned)(R * g.lda + C) * 2u; voffB[i] = (unsigned)(Rb * K + C) * 2u; }
    const size_t kstep = (size_t)(BK * 2);
    const size_t hstepB = (size_t)HALF * K * 2, hstepA = (size_t)HALF * g.lda * 2;
    const size_t tstepB = 2 * hstepB, tstepA = g.tstepA; const size_t kstepA = g.kstepA;
    const unsigned ldsw = (unsigned)wid * 1024u;
    const int aoff = lds_byte(wr * 64 + fr, fq * 8), boff = lds_byte(wc * 32 + fr, fq * 8);
#define PG8_SA(b, h) (((b) * 2 + (h)) * HTB)
#define PG8_SB(b, h) ((4 + (b) * 2 + (h)) * HTB)
#define PG8_STAGE(bufoff, gbase, voff) do { _Pragma("unroll") for (int _i = 0; _i < 2; ++_i) \
        __builtin_amdgcn_global_load_lds((const unsigned*)((const char*)(gbase) + (voff)[_i]), (PG8_LAS unsigned*)(lds + (bufoff) + ldsw + _i * 8192), 16, 0, 0); } while (0)
#define PG8_LDA(dst, b, h) do { _Pragma("unroll") for (int m = 0; m < 4; ++m) _Pragma("unroll") for (int k = 0; k < 2; ++k) dst[m][k] = *(const PG8_LAS bf16x8*)(lds + PG8_SA(b, h) + aoff + m * 2048 + k * 1024); } while (0)
#define PG8_LDB(dst, b, h) do { _Pragma("unroll") for (int n = 0; n < 2; ++n) _Pragma("unroll") for (int k = 0; k < 2; ++k) dst[n][k] = *(const PG8_LAS bf16x8*)(lds + PG8_SB(b, h) + boff + n * 2048 + k * 1024); } while (0)
#define PG8_MMA(ai, bj, At, Bt) do { __builtin_amdgcn_s_setprio(1); _Pragma("unroll") for (int m = 0; m < 4; ++m) _Pragma("unroll") for (int n = 0; n < 2; ++n) _Pragma("unroll") for (int k = 0; k < 2; ++k) \
        acc[ai][bj][m][n] = __builtin_amdgcn_mfma_f32_16x16x32_bf16(Bt[n][k], At[m][k], acc[ai][bj][m][n], 0, 0, 0); __builtin_amdgcn_s_setprio(0); } while (0)
#define PG8_WAIT_V(n) asm volatile("s_waitcnt vmcnt(" #n ")" ::: "memory")
#define PG8_WAIT_L(n) asm volatile("s_waitcnt lgkmcnt(" #n ")" ::: "memory")
#define PG8_BAR __builtin_amdgcn_s_barrier()
#define PG8_SCHED __builtin_amdgcn_sched_barrier(0)
    Unit cur, nxt; int ui = 0;
    if (!S.next(0, cur)) return;
    f32x4 acc[2][2][4][2];
#pragma unroll
    for (int a = 0; a < 2; ++a)
#pragma unroll
        for (int b = 0; b < 2; ++b)
#pragma unroll
            for (int m = 0; m < 4; ++m)
#pragma unroll
                for (int n = 0; n < 2; ++n) acc[a][b][m][n] = (f32x4){0.f, 0.f, 0.f, 0.f};
    bf16x8 At[4][2], B0[2][2], B1[2][2];
    const char* cA = (const char*)g.A + (size_t)cur.pm * tstepA + (size_t)(cur.k0 >> 6) * kstepA + (cur.qa > 0 ? hstepA : (size_t)0); const char* cB = (const char*)g.Bt + (size_t)cur.pn * tstepB + (size_t)cur.k0 * 2 + (cur.qb > 0 ? hstepB : (size_t)0);
    S.a_ready(cur);
    if constexpr (SP2) {
        PG8_STAGE(PG8_SB(0, 0), cB, voffB); PG8_STAGE(PG8_SB(0, 1), cB + hstepB, voffB); PG8_STAGE(PG8_SA(0, 0), cA, voffA); PG8_STAGE(PG8_SA(0, 1), cA + hstepA, voffA);
        if (wr == 1) PG8_BAR;
        PG8_WAIT_V(2); PG8_BAR;
        PG8_STAGE(PG8_SB(1, 0), cB + kstep, voffB); PG8_STAGE(PG8_SA(1, 0), cA + kstepA, voffA); PG8_STAGE(PG8_SB(1, 1), cB + hstepB + kstep, voffB);
        PG8_WAIT_V(6); PG8_BAR;
    } else {
        PG8_STAGE(PG8_SB(0, 0), cB, voffB); PG8_STAGE(PG8_SA(0, 0), cA, voffA); PG8_STAGE(PG8_SB(0, 1), cB + hstepB, voffB); PG8_STAGE(PG8_SA(0, 1), cA + hstepA, voffA);
        if (wr == 1) PG8_BAR;
        PG8_WAIT_V(4); PG8_BAR;
        PG8_STAGE(PG8_SB(1, 0), cB + kstep, voffB); PG8_STAGE(PG8_SA(1, 0), cA + kstepA, voffA); PG8_STAGE(PG8_SB(1, 1), cB + hstepB + kstep, voffB);
        PG8_WAIT_V(6); PG8_BAR;
    }
    for (;;) {
        const bool has_next = S.next(ui + 1, nxt);
        const char* nA = has_next ? (const char*)g.A + (size_t)nxt.pm * tstepA + (size_t)(nxt.k0 >> 6) * kstepA + (nxt.qa > 0 ? hstepA : (size_t)0) : cA; const char* nB = has_next ? (const char*)g.Bt + (size_t)nxt.pn * tstepB + (size_t)nxt.k0 * 2 + (nxt.qb > 0 ? hstepB : (size_t)0) : cB;
        const bool whole = cur.qa < 0;
        const int nt = cur.nt;
        for (int t = 0; t < nt; t += 2) {
            const bool last = (t == nt - 2);
            const char* a1 = cA + (size_t)(t + 1) * kstepA;
            const char* a2 = last ? nA : cA + (size_t)(t + 2) * kstepA; const char* b2 = last ? nB : cB + (size_t)(t + 2) * kstep;
            const char* a3 = a2 + kstepA; const char* b3 = b2 + kstep;
            if (last && has_next) S.a_ready(nxt);
            if constexpr (SP2) {
            PG8_LDB(B0, 0, 0); PG8_LDB(B1, 0, 1); PG8_SCHED; PG8_LDA(At, 0, 0); PG8_STAGE(PG8_SA(1, 1), a1 + hstepA, voffA);
            PG8_WAIT_V(8); PG8_WAIT_L(0); PG8_BAR; PG8_MMA(0, 0, At, B0); if (whole) PG8_MMA(0, 1, At, B1); PG8_BAR; PG8_SCHED;
            PG8_LDA(At, 0, 1); PG8_STAGE(PG8_SB(0, 0), b2, voffB); PG8_STAGE(PG8_SB(0, 1), b2 + hstepB, voffB); PG8_STAGE(PG8_SA(0, 0), a2, voffA);
            PG8_WAIT_V(8); PG8_WAIT_L(0); PG8_BAR; if (whole) { PG8_MMA(1, 0, At, B0); PG8_MMA(1, 1, At, B1); } PG8_BAR; PG8_SCHED;
            PG8_LDB(B0, 1, 0); PG8_LDB(B1, 1, 1); PG8_SCHED; PG8_LDA(At, 1, 0); PG8_STAGE(PG8_SA(0, 1), a2 + hstepA, voffA);
            PG8_WAIT_V(8); PG8_WAIT_L(0); PG8_BAR; PG8_MMA(0, 0, At, B0); if (whole) PG8_MMA(0, 1, At, B1); PG8_BAR; PG8_SCHED;
            PG8_LDA(At, 1, 1); PG8_STAGE(PG8_SB(1, 0), b3, voffB); PG8_STAGE(PG8_SB(1, 1), b3 + hstepB, voffB); PG8_STAGE(PG8_SA(1, 0), a3, voffA);
            PG8_WAIT_V(8); PG8_WAIT_L(0); PG8_BAR; if (whole) { PG8_MMA(1, 0, At, B0); PG8_MMA(1, 1, At, B1); } PG8_BAR; PG8_SCHED;
            } else {
            PG8_LDB(B0, 0, 0); PG8_SCHED; PG8_LDA(At, 0, 0); PG8_STAGE(PG8_SA(1, 1), a1 + hstepA, voffA);
            PG8_WAIT_L(8); PG8_BAR; PG8_WAIT_L(0); PG8_MMA(0, 0, At, B0); PG8_BAR; PG8_SCHED;
            PG8_LDB(B1, 0, 1); PG8_STAGE(PG8_SB(0, 0), b2, voffB);
            PG8_BAR; PG8_WAIT_L(0); PG8_MMA(0, 1, At, B1); PG8_BAR;
            PG8_LDA(At, 0, 1); PG8_STAGE(PG8_SA(0, 0), a2, voffA);
            PG8_BAR; PG8_WAIT_L(0); PG8_MMA(1, 0, At, B0); PG8_BAR; PG8_SCHED;
            PG8_STAGE(PG8_SB(0, 1), b2 + hstepB, voffB);
            PG8_WAIT_V(6); PG8_BAR; PG8_MMA(1, 1, At, B1); PG8_BAR;
            PG8_LDB(B0, 1, 0); PG8_SCHED; PG8_LDA(At, 1, 0); PG8_STAGE(PG8_SA(0, 1), a2 + hstepA, voffA);
            PG8_WAIT_L(8); PG8_BAR; PG8_WAIT_L(0); PG8_MMA(0, 0, At, B0); PG8_BAR; PG8_SCHED;
            PG8_LDB(B1, 1, 1); PG8_STAGE(PG8_SB(1, 0), b3, voffB);
            PG8_BAR; PG8_WAIT_L(0); PG8_MMA(0, 1, At, B1); PG8_BAR;
            PG8_LDA(At, 1, 1); PG8_STAGE(PG8_SA(1, 0), a3, voffA);
            PG8_BAR; PG8_WAIT_L(0); PG8_MMA(1, 0, At, B0); PG8_BAR; PG8_SCHED;
            PG8_STAGE(PG8_SB(1, 1), b3 + hstepB, voffB);
            PG8_WAIT_V(6); PG8_BAR; PG8_MMA(1, 1, At, B1); PG8_BAR;
            }
        }
        if constexpr (ALIGN_EPI) { if (wr == 0) PG8_BAR; }
        if constexpr (!Epi::AFTER_DRAIN) { E(acc, cur, wr, wc, fr, fq); S.done(cur); }
        if (!has_next) break;
#pragma unroll
        for (int a = 0; a < 2; ++a)
#pragma unroll
            for (int b = 0; b < 2; ++b)
#pragma unroll
                for (int m = 0; m < 4; ++m)
#pragma unroll
                    for (int n = 0; n < 2; ++n) acc[a][b][m][n] = (f32x4){0.f, 0.f, 0.f, 0.f};
        cur = nxt; cA = nA; cB = nB; ++ui;
        if constexpr (ALIGN_EPI) { if (wr == 1) PG8_BAR; }
    }
    PG8_WAIT_V(0);
    if constexpr (!ALIGN_EPI) { if (wr == 0) PG8_BAR; }
    PG8_BAR;
    if constexpr (Epi::AFTER_DRAIN) { E.fused(acc, cur, wr, wc, fr, fq, lds, wid, lane); S.done(cur); }
#undef PG8_SA
#undef PG8_SB
#undef PG8_STAGE
#undef PG8_LDA
#undef PG8_LDB
#undef PG8_MMA
#undef PG8_WAIT_V
#undef PG8_WAIT_L
#undef PG8_BAR
#undef PG8_SCHED
}
}
#define LAS __attribute__((address_space(3)))
typedef unsigned short bf16;
typedef unsigned v4u __attribute__((ext_vector_type(4)));
typedef unsigned v2u __attribute__((ext_vector_type(2)));
typedef float f32x4 __attribute__((ext_vector_type(4)));
typedef short bf16x8 __attribute__((ext_vector_type(8)));

constexpr int D = 1024, MP = 16384, MS = 1024, M = MP + MS, FF = 4096, NZ0 = 2560, NZ1 = 1536, SEQ = 2048;
constexpr float EPS = 1e-6f;
constexpr size_t OUT_Y = 0, OUT_CA_P = 17825792, OUT_CA_S = 17833984, OUT_CB_P = 17965056, OUT_CB_S = 18087936, OUT_PL_P = 20054016, OUT_PL_S = 20115456, OUT_V_S = 21098496, OUT_TOTAL = 21622784;
constexpr size_t MiB = 1u << 20;
constexpr size_t WS_SS = 0;
constexpr size_t WS_BAR = 512 * 1024;
constexpr size_t WS_WIN0 = 1 * MiB, WS_WOUT0 = 6 * MiB, WS_W1_0 = 8 * MiB, WS_W2_0 = 16 * MiB, WS_WIN1 = 24 * MiB, WS_WOUT1 = 27 * MiB, WS_W1_1 = 29 * MiB, WS_W2_1 = 37 * MiB, WS_SGUW = 45 * MiB;
constexpr size_t WS_XB = 46 * MiB;
constexpr size_t WS_H = 80 * MiB;
constexpr size_t WS_Z = 80 * MiB;
constexpr size_t WS_YMIX = 166 * MiB;
constexpr size_t WS_PART = 219 * MiB;
constexpr size_t WS_END = 251 * MiB;
constexpr int LDH = FF + 64;
constexpr int S_OUT = 4, S_FFN2 = 8;
constexpr int LDS_BYTES = 147456;

struct Params { const float* in[25]; float* out; unsigned char* ws; int ph_lo, ph_hi; };

__device__ __forceinline__ float wave_sum(float v) {
#pragma unroll
    for (int o = 1; o < 64; o <<= 1) v += __shfl_xor(v, o);
    return v;
}
__device__ __forceinline__ unsigned pk2(float lo, float hi) { return pg8::cvt_pk_bf16(lo, hi); }
__device__ __forceinline__ void unpack8(const v4u w, float (&f)[8]) {
    f[0] = __uint_as_float(w.x << 16); f[1] = __uint_as_float(w.x & 0xffff0000u); f[2] = __uint_as_float(w.y << 16); f[3] = __uint_as_float(w.y & 0xffff0000u);
    f[4] = __uint_as_float(w.z << 16); f[5] = __uint_as_float(w.z & 0xffff0000u); f[6] = __uint_as_float(w.w << 16); f[7] = __uint_as_float(w.w & 0xffff0000u);
}
__device__ __forceinline__ v4u pack8(const float (&f)[8]) { v4u w; w.x = pk2(f[0], f[1]); w.y = pk2(f[2], f[3]); w.z = pk2(f[4], f[5]); w.w = pk2(f[6], f[7]); return w; }
__device__ __forceinline__ void load8f(const float* p, float (&f)[8]) { const f32x4 a = *(const f32x4*)p, b = *(const f32x4*)(p + 4); f[0] = a[0]; f[1] = a[1]; f[2] = a[2]; f[3] = a[3]; f[4] = b[0]; f[5] = b[1]; f[6] = b[2]; f[7] = b[3]; }
__device__ __forceinline__ void store8f(float* p, const float (&f)[8]) { *(f32x4*)p = (f32x4){f[0], f[1], f[2], f[3]}; *(f32x4*)(p + 4) = (f32x4){f[4], f[5], f[6], f[7]}; }
__device__ __forceinline__ float sigmoidf_fast(float x) { return __builtin_amdgcn_rcpf(1.0f + __expf(-x)); }

typedef __attribute__((address_space(1))) unsigned gu32;
#define RLX_AGENT __ATOMIC_RELAXED, __HIP_MEMORY_SCOPE_AGENT
#define XB_TMO      128
#define XB_XCNT(j)  (256  + 64 * (j))
#define XB_XSUB(j)  (1280 + 64 * (j))
#define XB_XGEN(j)  (2304 + 64 * (j))
#define XB_TOP      3328
#define XB_TOPGEN   3392
#define XCD_BAR_WORDS 3456
#define XB_SPIN_CAP (1u << 18)

__device__ __forceinline__ unsigned xb_ld(unsigned* p)              { return __hip_atomic_load(p, __ATOMIC_RELAXED, __HIP_MEMORY_SCOPE_AGENT); }
__device__ __forceinline__ unsigned xb_add(unsigned* p, unsigned v) { return __hip_atomic_fetch_add(p, v, __ATOMIC_RELAXED, __HIP_MEMORY_SCOPE_AGENT); }
__device__ __forceinline__ unsigned xb_xcc_id() { return (unsigned)__builtin_amdgcn_s_getreg((3 << 11) | 20) & 0xFu; }
#define XB_SPIN(cond, bar) do { unsigned _sp = 0; while (cond) { __builtin_amdgcn_s_sleep(1); \
    if ((++_sp & 255u) == 0u) { if (xb_ld(&(bar)[XB_TMO])) break; if (_sp > XB_SPIN_CAP) { atomicAdd(&(bar)[XB_TMO], 1u); break; } } } } while (0)

struct XcdBarrier {
    unsigned* bar; unsigned x;
    volatile LAS unsigned* st;
};

__device__ __forceinline__ XcdBarrier xcd_barrier_post(unsigned* bar, volatile LAS unsigned* st) {
    XcdBarrier b; b.bar = bar; b.x = xb_xcc_id(); b.st = st;
    if (threadIdx.x == 0) (void)xb_add(&bar[XB_XCNT(b.x)], 1u);
    return b;
}
__device__ __forceinline__ void xcd_barrier_complete(unsigned* bar, unsigned x, unsigned& nloc, unsigned& nx) {
    const unsigned G = gridDim.x * gridDim.y * gridDim.z;
    unsigned sum, cnt, mine, sp = 0u;
    for (;;) {
        sum = 0u; cnt = 0u; mine = 0u;
#pragma unroll
        for (unsigned j = 0; j < 16; ++j) { const unsigned c = xb_ld(&bar[XB_XCNT(j)]); sum += c; cnt += (c > 0u) ? 1u : 0u; mine = (j == x) ? c : mine; }
        if (sum == G) break;
        __builtin_amdgcn_s_sleep(1);
        if ((++sp & 255u) == 0u) { if (xb_ld(&bar[XB_TMO])) break; if (sp > XB_SPIN_CAP) { atomicAdd(&bar[XB_TMO], 1u); break; } }
    }
    nloc = mine > 0u ? mine : 1u; nx = cnt > 0u ? cnt : 1u;
}

__device__ __forceinline__ void xcd_barrier(const XcdBarrier& b) {
    asm volatile("s_waitcnt vmcnt(0)" ::: "memory");
    __syncthreads();
    if (threadIdx.x == 0) {
        unsigned* bar = b.bar;
        __builtin_amdgcn_s_waitcnt(0);
        unsigned nloc = b.st[0], nx = b.st[1];
        if (nloc == 0u) { xcd_barrier_complete(bar, b.x, nloc, nx); b.st[0] = nloc; b.st[1] = nx; }
        const unsigned old = xb_add(&bar[XB_XSUB(b.x)], 1u);
        const unsigned gen = old / nloc;
        if (old + 1u == (gen + 1u) * nloc) {
            __builtin_amdgcn_fence(__ATOMIC_RELEASE, "agent");
            asm volatile("s_waitcnt vmcnt(0)" ::: "memory");
            const unsigned og = xb_add(&bar[XB_TOP], 1u);
            const unsigned tg = og / nx;
            if (og + 1u == (tg + 1u) * nx) xb_add(&bar[XB_TOPGEN], 1u);
            else XB_SPIN(xb_ld(&bar[XB_TOPGEN]) == tg, bar);
            __builtin_amdgcn_fence(__ATOMIC_ACQUIRE, "agent");
            xb_add(&bar[XB_XGEN(b.x)], 1u);
            asm volatile("s_waitcnt vmcnt(0)" ::: "memory");
        } else {
            XB_SPIN(xb_ld(&bar[XB_XGEN(b.x)]) == gen, bar);
            __builtin_amdgcn_fence(__ATOMIC_ACQUIRE, "agent");
            asm volatile("s_waitcnt vmcnt(0)" ::: "memory");
        }
    }
    __syncthreads();
}


__host__ __device__ __forceinline__ int gate_row(int n) { if (n < 512) return n; const int base = n < 1536 ? 512 : 1536, q = n - base, h = q >> 9, t = (q & 511) >> 7, r = q & 127; return base + t * 256 + h * 128 + r; }
template <bool GATEMAP = false>
__device__ __forceinline__ void p0_transpose_item(const float* W, int N, bf16* WT, int ldwt, int koff, const float* gain, LAS float* scr, int item, int lane) {
    const int nblk = N / 64, kb = item / nblk, nb = item % nblk, k0 = 64 * kb, n0 = 64 * nb; const int nd0 = GATEMAP ? gate_row(n0) : n0;
    const int ks = lane >> 4, n4 = (lane & 15) * 4;
    f32x4 v[16];
#pragma unroll
    for (int i = 0; i < 16; ++i) v[i] = *(const f32x4*)(W + (size_t)(k0 + 4 * i + ks) * N + n0 + n4);
    if (gain) {
#pragma unroll
        for (int i = 0; i < 16; ++i) v[i] = v[i] * gain[k0 + 4 * i + ks];
    }
#pragma unroll
    for (int i = 0; i < 16; ++i) { LAS float* d = scr + (4 * i + ks) * 65 + n4; d[0] = v[i][0]; d[1] = v[i][1]; d[2] = v[i][2]; d[3] = v[i][3]; }
    asm volatile("s_waitcnt lgkmcnt(0)" ::: "memory");
    const int c = lane & 7;
#pragma unroll
    for (int j = 0; j < 8; ++j) { const int n = (lane >> 3) + 8 * j; const LAS float* q = scr + (8 * c) * 65 + n;
        v4u o; o.x = pk2(q[0 * 65], q[1 * 65]); o.y = pk2(q[2 * 65], q[3 * 65]); o.z = pk2(q[4 * 65], q[5 * 65]); o.w = pk2(q[6 * 65], q[7 * 65]);
        *(v4u*)(WT + (size_t)(nd0 + n) * ldwt + koff + k0 + 8 * c) = o; }
    asm volatile("s_waitcnt lgkmcnt(0)" ::: "memory");
}
template <int PART>
__device__ __forceinline__ void phase_prologue_late(const Params& p, LAS unsigned char* lds, int cu0) {
    int tid_ = threadIdx.x; asm volatile("" : "+v"(tid_)); const int tid = tid_, lane = tid & 63, wave = __builtin_amdgcn_readfirstlane(tid >> 6);
    if ((int)blockIdx.x < cu0) return;
    const int nb = gridDim.x - cu0, gw = (blockIdx.x - cu0) * 8 + wave, NGW = nb * 8;
    LAS float* scr = (LAS float*)(lds + wave * 16640);
    unsigned char* ws = p.ws;
    constexpr int I_W1 = 16 * 64, I_W2 = 64 * 16, I_IN1 = 16 * 24, I_OUT1 = 8 * 16;
    if (PART == 1) {
        for (int it = gw; it < 16 * 16 + I_W1 + I_IN1 + I_OUT1; it += NGW) {
            int r = it;
            if (r < 16 * 16) { p0_transpose_item(p.in[13], D, (bf16*)(ws + WS_WOUT0), D, 0, nullptr, scr, r, lane); continue; } r -= 16 * 16;
            if (r < I_W1) { p0_transpose_item(p.in[22], FF, (bf16*)(ws + WS_W1_0), D, 0, p.in[6], scr, r, lane); continue; } r -= I_W1;
            if (r < I_IN1) { p0_transpose_item(p.in[14], NZ1, (bf16*)(ws + WS_WIN1), D, 0, p.in[5] + D, scr, r, lane); continue; } r -= I_IN1;
            p0_transpose_item(p.in[21] + (size_t)512 * D, D, (bf16*)(ws + WS_WOUT1), D, 512, nullptr, scr, r, lane);
        }
        return;
    }
    if (PART == 3) {
        for (int it = gw; it < I_W1 + I_W2; it += NGW) {
            int r = it;
            if (r < I_W1) { p0_transpose_item(p.in[22] + (size_t)D * FF, FF, (bf16*)(ws + WS_W1_1), D, 0, p.in[6] + D, scr, r, lane); continue; } r -= I_W1;
            p0_transpose_item(p.in[23] + (size_t)D * FF, D, (bf16*)(ws + WS_W2_1), FF, 0, nullptr, scr, r, lane);
        }
        return;
    }
    for (int it = gw; it < I_W2; it += NGW) p0_transpose_item(p.in[23], D, (bf16*)(ws + WS_W2_0), FF, 0, nullptr, scr, it, lane);
    {
        const float* Wp = p.in[15]; const float* sc = p.in[16]; const float* Wo = p.in[21]; bf16* WT = (bf16*)(ws + WS_WOUT1);
        for (int it = gw; it < 1024; it += NGW) {
            const int g = it >> 8, cb = (it >> 4) & 15, nb2 = it & 15, n = nb2 * 64 + lane;
            float acc[8];
#pragma unroll
            for (int i = 0; i < 8; ++i) acc[i] = 0.f;
            const float* wp = Wp + ((size_t)g * 128 + cb * 8) * 128;
            for (int d0 = 0; d0 < 128; d0 += 16) {
                float wv[16];
#pragma unroll
                for (int dd = 0; dd < 16; ++dd) wv[dd] = Wo[(size_t)(g * 128 + d0 + dd) * D + n];
#pragma unroll
                for (int dd = 0; dd < 16; ++dd) { const float w = wv[dd] * sc[g * 128 + d0 + dd];
#pragma unroll
                    for (int i = 0; i < 8; ++i) acc[i] += wp[i * 128 + d0 + dd] * w; }
            }
            *(v4u*)(WT + (size_t)n * D + g * 128 + cb * 8) = pack8(acc);
        }
    }
    {
        const float* Wsg = p.in[17]; bf16* o = (bf16*)(ws + WS_SGUW);
        for (int i = (blockIdx.x - cu0) * 512 + tid; i < 4 * 128 * 128 / 2; i += nb * 512) {
            const int e = 2 * i, t = (e >> 7) & 127, s2 = e & 127;
            const float a = (s2 <= t) ? Wsg[e] : 0.f, b = (s2 + 1 <= t) ? Wsg[e + 1] : 0.f;
            ((unsigned*)o)[i] = pk2(a, b);
        }
    }
}
__device__ __forceinline__ void phase_prologue(const Params& p, LAS unsigned char* lds) {
    int tid_ = threadIdx.x; asm volatile("" : "+v"(tid_)); const int tid = tid_, lane = tid & 63, wave = __builtin_amdgcn_readfirstlane(tid >> 6);
    const int gw = blockIdx.x * 8 + wave, NGW = gridDim.x * 8;
    LAS float* scr = (LAS float*)(lds + wave * 16640);
    unsigned char* ws = p.ws;
    for (int it = gw; it < 16 * 40; it += NGW) p0_transpose_item<true>(p.in[7], NZ0, (bf16*)(ws + WS_WIN0), D, 0, p.in[5], scr, it, lane);
    { float* ss = (float*)(ws + WS_SS); for (int i = blockIdx.x * 512 + tid; i < 6 * M; i += gridDim.x * 512) ss[M + i] = 0.f; }
    {
        float* ss0 = (float*)(ws + WS_SS); bf16* XB = (bf16*)(ws + WS_XB);
        for (int m0 = gw; m0 < M; m0 += 2 * NGW) {
            f32x4 v[2][4];
#pragma unroll
            for (int h = 0; h < 2; ++h) { const int m = m0 + h * NGW;
                if (m < M) { const float* xr = (m < MP) ? p.in[0] + (size_t)m * D : p.in[1] + (size_t)(m - MP) * D;
#pragma unroll
                    for (int j = 0; j < 4; ++j) v[h][j] = *((const f32x4*)xr + lane + 64 * j); } }
#pragma unroll
            for (int h = 0; h < 2; ++h) { const int m = m0 + h * NGW;
                if (m < M) { float s = 0.f; unsigned long long* o8 = (unsigned long long*)(XB + (size_t)m * D) + lane;
#pragma unroll
                    for (int j = 0; j < 4; ++j) { const f32x4 w = v[h][j]; s += (w[0] * w[0] + w[1] * w[1]) + (w[2] * w[2] + w[3] * w[3]);
                        o8[64 * j] = (unsigned long long)pk2(w[0], w[1]) | ((unsigned long long)pk2(w[2], w[3]) << 32); }
                    s = wave_sum(s);
                    if (lane == 0) ss0[m] = s; } }
        }
    }
}

__device__ __forceinline__ void phase_mixer0(const Params& p, LAS unsigned char* lds) {
    int tid_ = threadIdx.x; asm volatile("" : "+v"(tid_)); const int tid = tid_, lane = tid & 63, wave = __builtin_amdgcn_readfirstlane(tid >> 6);
    const bf16* Z = (const bf16*)(p.ws + WS_Z); bf16* Y = (bf16*)(p.ws + WS_YMIX);
    const float* st_a = p.in[2]; const float* st_b = p.in[3]; const float* cwa = p.in[8]; const float* cwb = p.in[9];
    const float* lng = p.in[11]; const float* lnb = p.in[12];
    float* o_ca_p = p.out + OUT_CA_P; float* o_ca_s = p.out + OUT_CA_S; float* o_cb_p = p.out + OUT_CB_P; float* o_cb_s = p.out + OUT_CB_S;
    LAS unsigned short* ub = (LAS unsigned short*)lds; LAS float* cb = (LAS float*)(lds + 63488);
    float wb[31];
#pragma unroll
    for (int k = 0; k < 31; ++k) wb[k] = cwb[k * 512 + tid];
    const float bias = p.in[10][tid];
    const int c8 = lane * 8;
    for (int unit = blockIdx.x; unit < 640; unit += gridDim.x) {
        const bool samp = unit >= 512;
        const int seq = samp ? unit - 512 : unit >> 6, t0 = samp ? 0 : (unit & 63) * 32, nout = samp ? 8 : 32;
        const long rowbase = samp ? (long)MP + seq * 8 : (long)seq * SEQ + t0;
        for (int j = wave; j < (samp ? 38 : 62); j += 8) {
            const int tt = t0 - 30 + j;
            float v[8];
            if (j < nout + 30 && tt >= 0) {
                unpack8(*(const v4u*)(Z + (rowbase + (tt - t0)) * NZ1 + 1024 + c8), v);
            } else if (samp && j < 30) {
                load8f(st_b + ((size_t)seq * 30 + j) * 512 + c8, v);
            } else {
#pragma unroll
                for (int i = 0; i < 8; ++i) v[i] = 0.f;
            }
            *(LAS v4u*)(ub + j * 512 + c8) = pack8(v);
            if (!samp) { if (tt >= SEQ - 30) store8f(o_cb_p + ((size_t)seq * 30 + (tt - (SEQ - 30))) * 512 + c8, v); }
            else if (j >= 8 && j < 38) store8f(o_cb_s + ((size_t)seq * 30 + (j - 8)) * 512 + c8, v);
        }
        __syncthreads();
        if (!samp) {
            float acc[32];
#pragma unroll
            for (int t = 0; t < 32; ++t) acc[t] = bias;
#pragma unroll
            for (int j = 0; j < 62; ++j) {
                const float v = __uint_as_float((unsigned)ub[j * 512 + tid] << 16);
#pragma unroll
                for (int t = 0; t < 32; ++t) { if (j - t >= 0 && j - t <= 30) acc[t] += v * wb[j - t]; }
            }
#pragma unroll
            for (int t = 0; t < 32; ++t) cb[t * 512 + tid] = acc[t];
        } else {
            float acc[8];
#pragma unroll
            for (int t = 0; t < 8; ++t) acc[t] = bias;
#pragma unroll
            for (int j = 0; j < 38; ++j) {
                const float v = __uint_as_float((unsigned)ub[j * 512 + tid] << 16);
#pragma unroll
                for (int t = 0; t < 8; ++t) { if (j - t >= 0 && j - t <= 30) acc[t] += v * wb[j - t]; }
            }
#pragma unroll
            for (int t = 0; t < 8; ++t) cb[t * 512 + tid] = acc[t];
        }
        __syncthreads();
        {
            float g8[8], b8[8]; load8f(lng + c8, g8); load8f(lnb + c8, b8);
            for (int i = 0; i < 4; ++i) {
                const int t = wave * 4 + i;
                if (t < nout) {
                    const f32x4 a = *(const LAS f32x4*)(cb + t * 512 + c8), b = *(const LAS f32x4*)(cb + t * 512 + c8 + 4);
                    float x[8] = {a[0], a[1], a[2], a[3], b[0], b[1], b[2], b[3]};
                    float s = 0.f;
#pragma unroll
                    for (int q = 0; q < 8; ++q) s += x[q];
                    const float mean = wave_sum(s) * (1.f / 512.f);
                    float s2 = 0.f;
#pragma unroll
                    for (int q = 0; q < 8; ++q) { x[q] -= mean; s2 += x[q] * x[q]; }
                    const float rstd = __builtin_amdgcn_rsqf(wave_sum(s2) * (1.f / 512.f) + EPS);
#pragma unroll
                    for (int q = 0; q < 8; ++q) { const float y = x[q] * rstd * g8[q] + b8[q]; x[q] = y * sigmoidf_fast(y); }
                    *(v4u*)(Y + (size_t)(rowbase + t) * D + 512 + c8) = pack8(x);
                }
            }
        }
        if (wave * 4 < nout) {
            float w0[8], w1[8], w2[8]; load8f(cwa + c8, w0); load8f(cwa + 512 + c8, w1); load8f(cwa + 1024 + c8, w2);
            float um2[8], um1[8];
#pragma unroll
            for (int h = 0; h < 2; ++h) {
                const int tt = t0 + wave * 4 - 2 + h; float u[8];
                if (tt >= 0) unpack8(*(const v4u*)(Z + (rowbase + (tt - t0)) * NZ1 + 512 + c8), u);
                else if (samp) load8f(st_a + ((size_t)seq * 2 + (2 + tt)) * 512 + c8, u);
                else {
#pragma unroll
                    for (int q = 0; q < 8; ++q) u[q] = 0.f; }
#pragma unroll
                for (int q = 0; q < 8; ++q) { if (h == 0) um2[q] = u[q]; else um1[q] = u[q]; }
            }
#pragma unroll
            for (int i = 0; i < 4; ++i) {
                const int t = wave * 4 + i; const bf16* zr = Z + (rowbase + t) * NZ1;
                float gbv[8], u0[8], y[8]; unpack8(*(const v4u*)(zr + c8), gbv); unpack8(*(const v4u*)(zr + 512 + c8), u0);
#pragma unroll
                for (int q = 0; q < 8; ++q) y[q] = gbv[q] * (w0[q] * um2[q] + w1[q] * um1[q] + w2[q] * u0[q]);
                *(v4u*)(Y + (size_t)(rowbase + t) * D + c8) = pack8(y);
                const int tt = t0 + t;
                if (!samp) { if (tt >= SEQ - 2) store8f(o_ca_p + ((size_t)seq * 2 + (tt - (SEQ - 2))) * 512 + c8, u0); }
                else if (t >= 6) store8f(o_ca_s + ((size_t)seq * 2 + (t - 6)) * 512 + c8, u0);
#pragma unroll
                for (int q = 0; q < 8; ++q) { um2[q] = um1[q]; um1[q] = u0[q]; }
            }
        }
        __syncthreads();
    }
}

template <int W>
__device__ __forceinline__ void pool_prompt(const bf16* Z, bf16* Y, float* o_pool_p, int seq, int ch, int g, int wave, int lane) {
    const int sub = lane >> 4, c8 = (lane & 15) * 8, col = g * 128 + c8;
    const int tq0 = ch * 128 + 16 * wave + 4 * sub;
    const size_t seqbase = (size_t)seq * SEQ;
    const bf16* zc = Z + seqbase * NZ1 + col;
    v4u rows[W + 3];
#pragma unroll
    for (int r = 0; r < W + 3; ++r) { const int tq = tq0 - (W - 1) + r; rows[r] = (tq >= 0) ? *(const v4u*)(zc + (size_t)tq * NZ1) : (v4u){0u, 0u, 0u, 0u}; }
    float S[8];
#pragma unroll
    for (int q = 0; q < 8; ++q) S[q] = 0.f;
#pragma unroll
    for (int r = 0; r < W; ++r) { float f[8]; unpack8(rows[r], f);
#pragma unroll
        for (int q = 0; q < 8; ++q) S[q] += f[q]; }
#pragma unroll
    for (int i = 0; i < 4; ++i) {
        const int tq = tq0 + i; const float inv = 1.0f / (float)((tq + 1 < W) ? tq + 1 : W);
        float cur[8], dd[8]; unpack8(rows[W - 1 + i], cur);
#pragma unroll
        for (int q = 0; q < 8; ++q) dd[q] = S[q] * inv - cur[q];
        *(v4u*)(Y + (seqbase + tq) * D + col) = pack8(dd);
        if (tq >= SEQ - 15) store8f(o_pool_p + ((size_t)seq * 15 + (tq - (SEQ - 15))) * 512 + col, cur);
        if (i < 3) { float a[8], bb[8]; unpack8(rows[W + i], a); unpack8(rows[i], bb);
#pragma unroll
            for (int q = 0; q < 8; ++q) S[q] += a[q] - bb[q]; }
    }
}
__device__ __forceinline__ int vnt_off(int d, int s) { return d * 128 + ((((s >> 3) ^ ((d >> 3) ^ d)) & 15) << 3) + (s & 7); }

__device__ __forceinline__ void phase_mixer1(const Params& p, LAS unsigned char* lds) {
    int tid_ = threadIdx.x; asm volatile("" : "+v"(tid_)); const int tid = tid_, lane = tid & 63, wave = __builtin_amdgcn_readfirstlane(tid >> 6);
    const bf16* Z = (const bf16*)(p.ws + WS_Z); bf16* Y = (bf16*)(p.ws + WS_YMIX);
    const float* st_pool = p.in[4]; const float* sgw = p.in[17]; const float* sgb = p.in[18]; const float* lng = p.in[19]; const float* lnb = p.in[20];
    const bf16* Wm = (const bf16*)(p.ws + WS_SGUW);
    const float* st1 = (const float*)(p.ws + WS_SS) + (size_t)5 * M; const float* st2 = st1 + M;
    float* o_pl_p = p.out + OUT_PL_P; float* o_pl_s = p.out + OUT_PL_S; float* o_v_s = p.out + OUT_V_S;
    LAS float* stats = (LAS float*)lds; LAS unsigned short* vnT = (LAS unsigned short*)(lds + 1024); LAS float* vns = (LAS float*)(lds + 40960);
    for (int unit = blockIdx.x; unit < 640; unit += gridDim.x) {
        if (unit < 512) {
            const int seq = unit >> 6, ch = (unit >> 2) & 15, g = (unit + 2 * (unit >> 8)) & 3;
            const size_t row0 = (size_t)seq * SEQ + ch * 128;
            if (tid < 128) {
                const float s1 = st1[row0 + tid], s2 = st2[row0 + tid];
                const float mean = s1 * (1.f / 512.f); const float var = fmaxf(s2 * (1.f / 512.f) - mean * mean, 0.f);
                stats[2 * tid] = mean; stats[2 * tid + 1] = __builtin_amdgcn_rsqf(var + EPS);
            }
            __syncthreads();
            {
                const int sub = lane >> 4, c8 = (lane & 15) * 8; float g8[8], b8[8]; load8f(lng + g * 128 + c8, g8); load8f(lnb + g * 128 + c8, b8);
#pragma unroll
                for (int ps = 0; ps < 4; ++ps) {
                    const int t = 16 * wave + 4 * ps + sub; const float mean = stats[2 * t], rstd = stats[2 * t + 1];
                    float x[8]; unpack8(*(const v4u*)(Z + (row0 + t) * NZ1 + 1024 + g * 128 + c8), x);
#pragma unroll
                    for (int q = 0; q < 8; ++q) { const float vn = (x[q] - mean) * rstd * g8[q] + b8[q]; vnT[vnt_off(c8 + q, t)] = (unsigned short)(pk2(vn, 0.f) & 0xffffu); }
                }
            }
            __syncthreads();
            {
                const int fr = lane & 15, fq = lane >> 4, t = 16 * wave + fr;
                f32x4 acc[8];
#pragma unroll
                for (int n = 0; n < 8; ++n) acc[n] = (f32x4){0.f, 0.f, 0.f, 0.f};
                const bf16* wrow = Wm + (size_t)g * 16384 + t * 128;
                const int ksteps = (wave >> 1) + 1;
                for (int k = 0; k < ksteps; ++k) {
                    const bf16x8 bfrag = *(const bf16x8*)(wrow + k * 32 + fq * 8);
#pragma unroll
                    for (int n = 0; n < 8; ++n) { const bf16x8 afrag = *(const LAS bf16x8*)(vnT + vnt_off(n * 16 + fr, k * 32 + fq * 8)); acc[n] = __builtin_amdgcn_mfma_f32_16x16x32_bf16(afrag, bfrag, acc[n], 0, 0, 0); }
                }
                const float bs = sgb[g * 128 + t];
#pragma unroll
                for (int n = 0; n < 8; ++n) {
                    const int col = g * 128 + n * 16 + 4 * fq; const v2u uw = *(const v2u*)(Z + (row0 + t) * NZ1 + 512 + col);
                    const float u0 = __uint_as_float(uw.x << 16), u1 = __uint_as_float(uw.x & 0xffff0000u), u2 = __uint_as_float(uw.y << 16), u3 = __uint_as_float(uw.y & 0xffff0000u);
                    v2u o; o.x = pk2(u0 * (acc[n][0] + bs), u1 * (acc[n][1] + bs)); o.y = pk2(u2 * (acc[n][2] + bs), u3 * (acc[n][3] + bs));
                    *(v2u*)(Y + (row0 + t) * D + 512 + col) = o;
                }
            }
            if (g == 0) pool_prompt<2>(Z, Y, o_pl_p, seq, ch, g, wave, lane);
            else if (g == 1) pool_prompt<4>(Z, Y, o_pl_p, seq, ch, g, wave, lane);
            else if (g == 2) pool_prompt<8>(Z, Y, o_pl_p, seq, ch, g, wave, lane);
            else pool_prompt<16>(Z, Y, o_pl_p, seq, ch, g, wave, lane);
            __syncthreads();
        } else {
            const int b = unit - 512, t = wave, c8 = lane * 8, g = lane >> 4;
            const size_t row = (size_t)MP + b * 8 + t; const bf16* zr = Z + row * NZ1;
            {
                float x[8], g8[8], b8[8]; unpack8(*(const v4u*)(zr + 1024 + c8), x); load8f(lng + c8, g8); load8f(lnb + c8, b8);
                float s = 0.f;
#pragma unroll
                for (int q = 0; q < 8; ++q) s += x[q];
                const float mean = wave_sum(s) * (1.f / 512.f); float s2 = 0.f;
#pragma unroll
                for (int q = 0; q < 8; ++q) { x[q] -= mean; s2 += x[q] * x[q]; }
                const float rstd = __builtin_amdgcn_rsqf(wave_sum(s2) * (1.f / 512.f) + EPS);
#pragma unroll
                for (int q = 0; q < 8; ++q) x[q] = x[q] * rstd * g8[q] + b8[q];
                store8f(o_v_s + ((size_t)b * 8 + t) * 512 + c8, x);
                *(LAS f32x4*)(vns + t * 512 + c8) = (f32x4){x[0], x[1], x[2], x[3]}; *(LAS f32x4*)(vns + t * 512 + c8 + 4) = (f32x4){x[4], x[5], x[6], x[7]};
            }
            __syncthreads();
            {
                float mx[8]; const float bs = sgb[g * 128 + t];
#pragma unroll
                for (int q = 0; q < 8; ++q) mx[q] = bs;
                for (int s = 0; s <= t; ++s) {
                    const float w = sgw[(size_t)g * 16384 + t * 128 + s];
                    const f32x4 a = *(const LAS f32x4*)(vns + s * 512 + c8), c = *(const LAS f32x4*)(vns + s * 512 + c8 + 4);
                    mx[0] += w * a[0]; mx[1] += w * a[1]; mx[2] += w * a[2]; mx[3] += w * a[3]; mx[4] += w * c[0]; mx[5] += w * c[1]; mx[6] += w * c[2]; mx[7] += w * c[3];
                }
                float u[8]; unpack8(*(const v4u*)(zr + 512 + c8), u);
#pragma unroll
                for (int q = 0; q < 8; ++q) u[q] *= mx[q];
                *(v4u*)(Y + row * D + 512 + c8) = pack8(u);
            }
            {
                const int W = 2 << g; float S[8];
#pragma unroll
                for (int q = 0; q < 8; ++q) S[q] = 0.f;
#pragma nounroll
                for (int i = 0; i < W; ++i) {
                    const int tt = t - i; float f[8];
                    if (tt >= 0) unpack8(*(const v4u*)(Z + ((size_t)MP + b * 8 + tt) * NZ1 + c8), f); else load8f(st_pool + ((size_t)b * 15 + 15 + tt) * 512 + c8, f);
#pragma unroll
                    for (int q = 0; q < 8; ++q) S[q] += f[q];
                }
                float cur[8]; unpack8(*(const v4u*)(zr + c8), cur); const float inv = 1.0f / (float)W;
#pragma unroll
                for (int q = 0; q < 8; ++q) S[q] = S[q] * inv - cur[q];
                *(v4u*)(Y + row * D + c8) = pack8(S);
                for (int j = wave; j < 15; j += 8) {
                    float f[8];
                    if (j < 7) load8f(st_pool + ((size_t)b * 15 + 8 + j) * 512 + c8, f); else unpack8(*(const v4u*)(Z + ((size_t)MP + b * 8 + (j - 7)) * NZ1 + c8), f);
                    store8f(o_pl_s + ((size_t)b * 15 + j) * 512 + c8, f);
                }
            }
            __syncthreads();
        }
    }
}

template <bool FINAL>
__device__ __forceinline__ void sample_fixup(const Params& p, int S, float* ss_s, const float* gf) {
    int tid_ = threadIdx.x; asm volatile("" : "+v"(tid_)); const int tid = tid_, lane = tid & 63, wave = tid >> 6;
    const int gw = blockIdx.x * 8 + wave, NGW = gridDim.x * 8;
    const float* part = (const float*)(p.ws + WS_PART); bf16* XB = (bf16*)(p.ws + WS_XB) + (size_t)MP * D; float* xo = p.out + (size_t)MP * D;
    for (int r = gw; r < MS; r += NGW) {
        f32x4 v[4];
        unsigned long long* o8 = (unsigned long long*)(XB + (size_t)r * D) + lane;
#pragma unroll
        for (int j = 0; j < 4; ++j) { const unsigned long long w = o8[64 * j]; const unsigned lo = (unsigned)w, hi = (unsigned)(w >> 32);
            v[j] = (f32x4){__uint_as_float(lo << 16), __uint_as_float(lo & 0xffff0000u), __uint_as_float(hi << 16), __uint_as_float(hi & 0xffff0000u)}; }
        for (int sp = 0; sp < S; ++sp) {
            const unsigned long long* pr = (const unsigned long long*)((const bf16*)part + ((size_t)sp * MS + r) * D) + lane;
#pragma unroll
            for (int j = 0; j < 4; ++j) { const unsigned long long w = pr[64 * j]; const unsigned lo = (unsigned)w, hi = (unsigned)(w >> 32);
                v[j] += (f32x4){__uint_as_float(lo << 16), __uint_as_float(lo & 0xffff0000u), __uint_as_float(hi << 16), __uint_as_float(hi & 0xffff0000u)}; }
        }
        float s = 0.f;
#pragma unroll
        for (int j = 0; j < 4; ++j) s += (v[j][0] * v[j][0] + v[j][1] * v[j][1]) + (v[j][2] * v[j][2] + v[j][3] * v[j][3]);
        s = wave_sum(s);
        if (!FINAL) {
#pragma unroll
            for (int j = 0; j < 4; ++j) o8[64 * j] = (unsigned long long)pk2(v[j][0], v[j][1]) | ((unsigned long long)pk2(v[j][2], v[j][3]) << 32);
            if (lane == 0) ss_s[r] = s;
        } else {
            const float rs = __builtin_amdgcn_rsqf(s * (1.f / 1024.f) + EPS);
#pragma unroll
            for (int j = 0; j < 4; ++j) *((f32x4*)(xo + (size_t)r * D) + lane + 64 * j) = v[j] * rs * *((const f32x4*)gf + lane + 64 * j);
        }
    }
}
__device__ __forceinline__ void phase_final(const Params& p) {
    int tid_ = threadIdx.x; asm volatile("" : "+v"(tid_)); const int tid = tid_, lane = tid & 63, wave = tid >> 6;
    const int gw = blockIdx.x * 8 + wave, NGW = gridDim.x * 8;
    const float* ss4 = (const float*)(p.ws + WS_SS) + 4 * (size_t)M; const float* gf = p.in[24];
    f32x4 g4[4];
#pragma unroll
    for (int j = 0; j < 4; ++j) g4[j] = *((const f32x4*)gf + lane + 64 * j);
    const bf16* XB = (const bf16*)(p.ws + WS_XB);
    for (int m = gw; m < MP; m += NGW) {
        const float rs = __builtin_amdgcn_rsqf(ss4[m] * (1.f / 1024.f) + EPS);
        const unsigned long long* x8 = (const unsigned long long*)(XB + (size_t)m * D) + lane;
        f32x4* xr = (f32x4*)(p.out + (size_t)m * D) + lane;
#pragma unroll
        for (int j = 0; j < 4; ++j) { const unsigned long long w = x8[64 * j]; const unsigned lo = (unsigned)w, hi = (unsigned)(w >> 32);
            const f32x4 v = (f32x4){__uint_as_float(lo << 16), __uint_as_float(lo & 0xffff0000u), __uint_as_float(hi << 16), __uint_as_float(hi & 0xffff0000u)};
            xr[64 * j] = v * rs * g4[j]; }
    }
    sample_fixup<true>(p, S_FFN2, nullptr, gf);
}

template <int layer>
__device__ __forceinline__ void run_layer(const Params& p, LAS unsigned char* lds, const XcdBarrier& xbar, const int lo, const int hi) {
#define IN(k) (lo <= (k) && (k) < hi)
#define SEAM(k) do { if (lo <= (k) && (k) + 1 < hi) xcd_barrier(xbar); } while (0)
    unsigned char* ws = p.ws;
    float* ssb = (float*)(ws + WS_SS);
    bf16* XB = (bf16*)(ws + WS_XB); bf16* Zb = (bf16*)(ws + WS_Z); bf16* Yb = (bf16*)(ws + WS_YMIX); bf16* Hb = (bf16*)(ws + WS_H);
        const int pb = 1 + 7 * layer;
        const bf16* Win = (const bf16*)(ws + (layer ? WS_WIN1 : WS_WIN0)); const bf16* Wout = (const bf16*)(ws + (layer ? WS_WOUT1 : WS_WOUT0));
        const bf16* W1 = (const bf16*)(ws + (layer ? WS_W1_1 : WS_W1_0)); const bf16* W2 = (const bf16*)(ws + (layer ? WS_W2_1 : WS_W2_0));
        const int NZ = layer ? NZ1 : NZ0;
        float* ss_in = ssb + (size_t)(2 * layer) * M; float* ss_mid = ss_in + M; float* ss_out = ss_mid + M;
        float* part = (float*)(ws + WS_PART);
        if (IN(pb)) {
            pg8::Gemm g{XB, Win, M, NZ, D, D, 128, (size_t)256 * D * 2, 0}; pg8::StaticOrder S; S.init(M, NZ, D, gridDim.x, blockIdx.x);
            if constexpr (layer == 0) { pg8::EpiGate E{Zb, ss_in}; pg8::gemm_phase<pg8::EpiGate, pg8::StaticOrder, true, true>(lds, g, S, E); }
            else { pg8::EpiScaleBf16<0, false, true> E{Zb, NZ, ss_in, ssb + (size_t)5 * M, ssb + (size_t)6 * M, 4};
                pg8::gemm_phase<pg8::EpiScaleBf16<0, false, true>, pg8::StaticOrder, true, true>(lds, g, S, E); }
            if (layer == 0) {
                const int G = gridDim.x, nu = (M / 256) * (NZ0 / 256), rounds = (nu + G - 1) / G; int full = nu - (rounds - 1) * G; if (full >= G) full = 0;
                phase_prologue_late<1>(p, lds, full);
            } else {
                const int G = gridDim.x, nu = (M / 256) * (NZ1 / 256), rounds = (nu + G - 1) / G; int full = nu - (rounds - 1) * G; if (full >= G) full = 0;
                phase_prologue_late<3>(p, lds, full);
            }
        }
        SEAM(pb);
        if (IN(pb + 1)) { if (layer == 0) phase_mixer0(p, lds); else phase_mixer1(p, lds); }
        SEAM(pb + 1);
        if (IN(pb + 2)) {
            pg8::Gemm g{Yb, Wout, M, D, D, D, 128, (size_t)256 * D * 2, 0}; pg8::ResidOrder S; S.init(D, S_OUT, gridDim.x, blockIdx.x);
            pg8::EpiResid<false> E{XB, nullptr, ss_mid, part, nullptr, nullptr};
            pg8::gemm_phase<pg8::EpiResid<false>, pg8::ResidOrder, true, true>(lds, g, S, E);
        }
        SEAM(pb + 2);
        if (IN(pb + 4)) {
            {
                sample_fixup<false>(p, S_OUT, ss_mid + MP, nullptr);
                asm volatile("s_waitcnt vmcnt(0)" ::: "memory");
                __syncthreads();
                if (threadIdx.x == 0) {
                    __builtin_amdgcn_fence(__ATOMIC_RELEASE, "agent");
                    asm volatile("s_waitcnt vmcnt(0)" ::: "memory");
                    __hip_atomic_fetch_add((unsigned*)(ws + WS_BAR + 16384 + 4096 * layer), 1u, __ATOMIC_RELAXED, __HIP_MEMORY_SCOPE_AGENT);
                }
            }
            pg8::Gemm g{XB, W1, M, FF, D, D, 128, (size_t)256 * D * 2, 0};
            pg8::EpiScaleBf16<1, true> E{Hb, FF, ss_mid, nullptr, nullptr, 0};
            if constexpr (layer == 0) {
                pg8::FixOrder S; S.init(M, FF, D, gridDim.x, blockIdx.x); S.cnt = (const unsigned*)(ws + WS_BAR + 16384 + 4096 * layer); S.need = gridDim.x;
                pg8::gemm_phase<pg8::EpiScaleBf16<1, true>, pg8::FixOrder, true, true>(lds, g, S, E);
            } else {
                pg8::QuarterOrder S; S.initq(FF, D, gridDim.x, blockIdx.x); S.cnt = (const unsigned*)(ws + WS_BAR + 16384 + 4096 * layer); S.need = gridDim.x;
                pg8::gemm_phase<pg8::EpiScaleBf16<1, true>, pg8::QuarterOrder, true, true>(lds, g, S, E);
            }
            if (layer == 0) {
                const int G = gridDim.x, nu = (M / 256) * (FF / 256), rounds = (nu + G - 1) / G; int full = nu - (rounds - 1) * G; if (full >= G) full = 0;
                phase_prologue_late<2>(p, lds, full);
            }
        }
        SEAM(pb + 4);
        if (IN(pb + 5)) {
            pg8::Gemm g{Hb, W2, M, D, FF, 32, 32768, (size_t)64 * 32768, 1}; pg8::ResidOrder S; S.init(FF, S_FFN2, gridDim.x, blockIdx.x);
            pg8::EpiResid<false> E{XB, nullptr, ss_out, part, nullptr, nullptr};
            pg8::gemm_phase<pg8::EpiResid<false>, pg8::ResidOrder, true, true>(lds, g, S, E);
        }
        SEAM(pb + 5);
        if (layer == 0) { if (IN(pb + 6)) sample_fixup<false>(p, S_FFN2, ss_out + MP, nullptr); SEAM(pb + 6); }
#undef IN
#undef SEAM
}
__global__ void __launch_bounds__(512, 2) mega_fwd(Params p) {
    extern __shared__ __attribute__((aligned(16))) unsigned char lds_raw[];
    LAS unsigned char* lds = (LAS unsigned char*)lds_raw;
    cg::grid_group grid = cg::this_grid();
    const int lo = p.ph_lo, hi = p.ph_hi;
    volatile LAS unsigned* bst = (volatile LAS unsigned*)(lds + LDS_BYTES - 16);
    if (threadIdx.x < 2) bst[threadIdx.x] = 0u;
    __syncthreads();
    XcdBarrier xbar = xcd_barrier_post((unsigned*)(p.ws + WS_BAR), bst);
#define IN(k) (lo <= (k) && (k) < hi)
#define SEAM(k) do { if (lo <= (k) && (k) + 1 < hi) xcd_barrier(xbar); } while (0)
    unsigned char* ws = p.ws;
    float* ssb = (float*)(ws + WS_SS);
    bf16* XB = (bf16*)(ws + WS_XB); bf16* Zb = (bf16*)(ws + WS_Z); bf16* Yb = (bf16*)(ws + WS_YMIX); bf16* Hb = (bf16*)(ws + WS_H);
    if (p.ph_hi > 1000) grid.sync();
    if (IN(0)) phase_prologue(p, lds);
    SEAM(0);
    run_layer<0>(p, lds, xbar, lo, hi);
    run_layer<1>(p, lds, xbar, lo, hi);
    if (IN(14)) phase_final(p);
#undef IN
#undef SEAM
}

#ifndef N_LAUNCH_MODE
#define N_LAUNCH_MODE 1
#endif
extern "C" void kernel_launch(void* const* d_in, const int* in_sizes, int n_in, void* d_out, int out_size, void* d_ws, size_t ws_size, hipStream_t stream) {
    static int grid = 0;
    if (grid == 0) {
        if (n_in != 25 || out_size != (int)OUT_TOTAL || ws_size < WS_END) { fprintf(stderr, "kernel_launch: unexpected shapes (n_in %d out %d ws %zu)\n", n_in, out_size, ws_size); grid = -1; return; }
        int dev = 0, cus = 0, per_cu = 0;
        if (hipGetDevice(&dev) != hipSuccess || hipDeviceGetAttribute(&cus, hipDeviceAttributeMultiprocessorCount, dev) != hipSuccess) { grid = -1; return; }
        if (hipFuncSetAttribute((const void*)mega_fwd, hipFuncAttributeMaxDynamicSharedMemorySize, LDS_BYTES) != hipSuccess) { fprintf(stderr, "kernel_launch: hipFuncSetAttribute failed\n"); grid = -1; return; }
        if (hipOccupancyMaxActiveBlocksPerMultiprocessor(&per_cu, (const void*)mega_fwd, 512, LDS_BYTES) != hipSuccess || per_cu < 1) { fprintf(stderr, "kernel_launch: occupancy query says %d\n", per_cu); (void)hipGetLastError(); per_cu = 1; }
        grid = cus * 1;
        if (cus < 256) fprintf(stderr, "kernel_launch: built for a 256-CU device (fused final norm exchange); %d CUs will give wrong rows\n", cus);
        if (grid > 256) grid = 256;
        if (grid > cus * per_cu) grid = cus * per_cu;
    }
    if (grid < 0) return;
    Params p{};
    for (int i = 0; i < 25; ++i) p.in[i] = (const float*)d_in[i];
    p.out = (float*)d_out; p.ws = (unsigned char*)d_ws;
#if N_LAUNCH_MODE == 1
    if (hipMemsetAsync((unsigned char*)d_ws + WS_BAR, 0, 32768, stream) != hipSuccess) { fprintf(stderr, "kernel_launch: memset failed\n"); return; }
    p.ph_lo = 0; p.ph_hi = 15;
    void* args[] = {&p};
    hipError_t e = hipLaunchCooperativeKernel((const void*)mega_fwd, dim3(grid), dim3(512), args, LDS_BYTES, stream);
    if (e != hipSuccess) fprintf(stderr, "cooperative launch failed: %s (grid %d)\n", hipGetErrorString(e), grid);
#else
    for (int ph = 0; ph < 15; ++ph) { p.ph_lo = ph; p.ph_hi = ph + 1; hipLaunchKernelGGL(mega_fwd, dim3(grid), dim3(512), LDS_BYTES, stream, p); }
#endif
}
```
